# Optimizing an MI355X kernel written in HIP

```python
import jax, jax.numpy as jnp
from jax import lax
import numpy as np

D_MODEL = 1024
BATCH = 8
SEQ = 4096
DEPTH = 1

CHUNK = 64
Q_BLOCK = 128
MLA_HEADS = 8
QK_NOPE_DIM = 64
QK_ROPE_DIM = 32
V_HEAD_DIM = 64
Q_LORA_RANK = 384
KV_LORA_RANK = 256
MLA_WIDTH = MLA_HEADS * V_HEAD_DIM
ROPE_THETA = 10000.0
POOL_WINDOWS = (2, 4, 8, 16)
POOL_GROUPS = len(POOL_WINDOWS)
POOL_WIDTH = D_MODEL // 2
POOL_GROUP_DIM = POOL_WIDTH // POOL_GROUPS
N_BRANCHES = 2
EPS = 1e-6

IN_SIZES = (Q_LORA_RANK, KV_LORA_RANK, QK_ROPE_DIM, MLA_WIDTH, POOL_WIDTH, POOL_WIDTH, N_BRANCHES * D_MODEL)
IN_SPLITS = tuple(int(s) for s in np.cumsum(IN_SIZES)[:-1])
IN_TOTAL = int(sum(IN_SIZES))

kernel_name = "hybrid_mla_pool_gated_block"


def rms_norm(x, g):
    xf = x.astype(jnp.float32)
    y = xf * lax.rsqrt(jnp.mean(xf * xf, axis=-1, keepdims=True) + EPS)
    return (y * g.astype(jnp.float32)).astype(x.dtype)


def rope_tables(seq):
    half = QK_ROPE_DIM // 2
    inv_freq = ROPE_THETA ** (-jnp.arange(half, dtype=jnp.float32) / half)
    ang = jnp.arange(seq, dtype=jnp.float32)[:, None] * inv_freq[None, :]
    return jnp.cos(ang), jnp.sin(ang)


def apply_rope(x, cos, sin):
    xf = x.astype(jnp.float32)
    x1, x2 = jnp.split(xf, 2, axis=-1)
    out = jnp.concatenate([x1 * cos - x2 * sin, x1 * sin + x2 * cos], axis=-1)
    return out.astype(x.dtype)


def mla_attention(zq, zkv, zkr, q_norm, w_uq, kv_norm, w_ukv):
    b, s, _ = zq.shape
    cos, sin = rope_tables(s)
    c_q = rms_norm(zq, q_norm)
    q = jnp.einsum('bsr,rhd->bshd', c_q, w_uq)
    q_nope = q[..., :QK_NOPE_DIM]
    q_rope = apply_rope(q[..., QK_NOPE_DIM:], cos[None, :, None, :], sin[None, :, None, :])
    c_kv = rms_norm(zkv, kv_norm)
    kv = jnp.einsum('bsr,rhd->bshd', c_kv, w_ukv)
    k_nope = kv[..., :QK_NOPE_DIM]
    v = kv[..., QK_NOPE_DIM:]
    k_rope = apply_rope(zkr, cos[None], sin[None])
    scale = (QK_NOPE_DIM + QK_ROPE_DIM) ** -0.5
    key_chunk = jnp.arange(s) // CHUNK
    n_blocks = s // Q_BLOCK

    def one_block(i):
        start = i * Q_BLOCK
        qn = lax.dynamic_slice_in_dim(q_nope, start, Q_BLOCK, axis=1)
        qr = lax.dynamic_slice_in_dim(q_rope, start, Q_BLOCK, axis=1)
        sc = (jnp.einsum('bqhd,bkhd->bhqk', qn, k_nope).astype(jnp.float32)
              + jnp.einsum('bqhr,bkr->bhqk', qr, k_rope).astype(jnp.float32)) * scale
        q_chunk = (start + jnp.arange(Q_BLOCK)) // CHUNK
        mask = key_chunk[None, :] <= q_chunk[:, None]
        sc = jnp.where(mask[None, None], sc, -jnp.inf)
        p = jax.nn.softmax(sc, axis=-1).astype(v.dtype)
        return jnp.einsum('bhqk,bkhd->bqhd', p, v)

    o = lax.map(one_block, jnp.arange(n_blocks))
    o = jnp.transpose(o, (1, 0, 2, 3, 4)).reshape(b, s, MLA_WIDTH)
    return o


def multiscale_pool(u, pool_w, pool_scale):
    b, s, _ = u.shape
    uf = u.astype(jnp.float32)
    csum = jnp.cumsum(uf, axis=1)
    t = jnp.arange(s)
    outs = []
    for gi, w in enumerate(POOL_WINDOWS):
        sl = slice(gi * POOL_GROUP_DIM, (gi + 1) * POOL_GROUP_DIM)
        cg = csum[..., sl]
        shifted = jnp.pad(cg, ((0, 0), (w, 0), (0, 0)))[:, :s]
        count = jnp.minimum(t + 1, w).astype(jnp.float32)[None, :, None]
        d = (cg - shifted) / count - uf[..., sl]
        outs.append(jnp.einsum('bsc,cd->bsd', d, pool_w[gi].astype(jnp.float32)))
    y = jnp.concatenate(outs, axis=-1) * pool_scale.astype(jnp.float32)
    return y.astype(u.dtype)


def setup_inputs(seed: int = 0) -> dict:
    key = jax.random.key(seed)
    ks = jax.random.split(key, 14)
    f = jnp.float32
    def nrm(k, shape, fan_in):
        return jax.random.normal(k, shape, f) * (fan_in ** -0.5)
    return {
        "x": jax.random.normal(ks[0], (BATCH, SEQ, D_MODEL), f),
        "norm_in": 1.0 + 0.02 * jax.random.normal(ks[1], (D_MODEL,), f),
        "w_in": nrm(ks[2], (D_MODEL, IN_TOTAL), D_MODEL),
        "q_norm": 1.0 + 0.02 * jax.random.normal(ks[3], (Q_LORA_RANK,), f),
        "w_uq": nrm(ks[4], (Q_LORA_RANK, MLA_HEADS, QK_NOPE_DIM + QK_ROPE_DIM), Q_LORA_RANK),
        "kv_norm": 1.0 + 0.02 * jax.random.normal(ks[5], (KV_LORA_RANK,), f),
        "w_ukv": nrm(ks[6], (KV_LORA_RANK, MLA_HEADS, QK_NOPE_DIM + V_HEAD_DIM), KV_LORA_RANK),
        "pool_w": nrm(ks[7], (POOL_GROUPS, POOL_GROUP_DIM, POOL_GROUP_DIM), POOL_GROUP_DIM),
        "pool_scale": 1.0 + 0.02 * jax.random.normal(ks[8], (POOL_WIDTH,), f),
        "w_branch_attn": nrm(ks[9], (MLA_WIDTH, D_MODEL), MLA_WIDTH),
        "w_branch_pool": nrm(ks[10], (POOL_WIDTH, D_MODEL), POOL_WIDTH),
        "w_out": nrm(ks[11], (D_MODEL, D_MODEL), D_MODEL),
        "norm_final": 1.0 + 0.02 * jax.random.normal(ks[12], (D_MODEL,), f),
    }


def reference(x, norm_in, w_in, q_norm, w_uq, kv_norm, w_ukv, pool_w, pool_scale,
              w_branch_attn, w_branch_pool, w_out, norm_final):
    h = x
    for _ in range(DEPTH):
        hn = rms_norm(h, norm_in)
        z = jnp.einsum('bsd,de->bse', hn, w_in)
        zq, zkv, zkr, g_attn, u_pool, g_pool, g_merge = jnp.split(z, IN_SPLITS, axis=-1)
        y_attn = mla_attention(zq, zkv, zkr, q_norm, w_uq, kv_norm, w_ukv) * jax.nn.silu(g_attn)
        y_pool = multiscale_pool(u_pool, pool_w, pool_scale) * jax.nn.silu(g_pool)
        a = jnp.einsum('bsc,cd->bsd', y_attn, w_branch_attn)
        p = jnp.einsum('bsc,cd->bsd', y_pool, w_branch_pool)
        gate_a, gate_p = jnp.split(jax.nn.sigmoid(g_merge.astype(jnp.float32)).astype(h.dtype), 2, axis=-1)
        merged = gate_a * a + gate_p * p
        h = h + jnp.einsum('bsd,de->bse', merged, w_out)
    return rms_norm(h, norm_final)
```

```cpp
#include <hip/hip_runtime.h>
#include <hip/hip_cooperative_groups.h>
#include <cstdio>
#include <cstdint>
namespace cg = cooperative_groups;
__device__ __forceinline__ int mk_lane_id() { int l; asm volatile("v_mbcnt_lo_u32_b32 %0, -1, 0\n\tv_mbcnt_hi_u32_b32 %0, -1, %0" : "=v"(l)); return l; }
namespace pg8 {
#define PG8_LAS __attribute__((address_space(3)))
typedef unsigned short bf16_t;
typedef short bf16x8 __attribute__((ext_vector_type(8)));
typedef float f32x4 __attribute__((ext_vector_type(4)));
typedef unsigned u32x4 __attribute__((ext_vector_type(4)));
constexpr int BM = 256, BK = 64, HALF = 128, HTB = HALF * BK * 2  , STAGE_BYTES = 8 * HTB, NXCD = 8, WGM = 8;

__host__ __device__ __forceinline__ int lds_byte(int r, int c) { const int st = (r >> 4) * 2 + (c >> 5), rr = r & 15, cc = c & 31, ob = rr * 64 + cc * 2; return st * 1024 + (ob ^ (((ob >> 9) & 1) << 5)); }
__host__ __device__ __forceinline__ void stage_rc(int b, int& R, int& C) { const int st = b / 1024, sb = b % 1024, swz = sb ^ (((sb >> 9) & 1) << 5); R = (st >> 1) * 16 + swz / 64; C = (st & 1) * 32 + (swz % 64) / 2; }
__host__ __device__ __forceinline__ int perm32(int rho) { const int n = rho >> 4, i = rho & 15; return 8 * (i >> 2) + 4 * n + (i & 3); }

struct Unit { int pm, pn; };
struct Gemm { const bf16_t* A; const bf16_t* Bt; int M, N, K, lda, ldb; };

struct StaticOrder {
    int nM, nN, nwg, G, c;
    __host__ __device__ void init(int M, int N, int G_, int c_) { nM = M / BM; nN = N / BM; nwg = nM * nN; G = G_; c = c_; }
    __host__ __device__ bool next(int i, Unit& u) const {
        const long L = (long)i * G + c; if (L >= nwg) return false;
        int wgid = (int)L; { const int q = nwg / NXCD, r = nwg % NXCD, xcd = wgid % NXCD, off = wgid / NXCD; wgid = (xcd < r ? xcd * (q + 1) : r * (q + 1) + (xcd - r) * q) + off; }
        const int nig = WGM * nN, gid = wgid / nig, fm = gid * WGM, gsz = (nM - fm) < WGM ? (nM - fm) : WGM;
        u.pm = fm + ((wgid % nig) % gsz); u.pn = (wgid % nig) / gsz; return true;
    }
    __device__ __forceinline__ void a_ready(const Unit&) const {}
    __device__ __forceinline__ void done(const Unit&) const {}
};

typedef float f32x2_cv __attribute__((ext_vector_type(2))); typedef __bf16 bf16x2_cv __attribute__((ext_vector_type(2)));
__device__ __forceinline__ unsigned cvt_pk_bf16(float lo, float hi) { f32x2_cv v = {lo, hi}; bf16x2_cv b = __builtin_convertvector(v, bf16x2_cv); return __builtin_bit_cast(unsigned, b); }
typedef float f32x2 __attribute__((ext_vector_type(2)));
template <class Epi, class Sched, bool ALIGN_EPI = false, bool SP2 = false>
__device__ __forceinline__ void gemm_phase(PG8_LAS unsigned char* lds, const Gemm g, const Sched& S, const Epi& E, const int wave_s) {
    int tid = wave_s * 64 + mk_lane_id(); asm volatile("" : "+v"(tid));
    const int wid = __builtin_amdgcn_readfirstlane(tid >> 6), lane = tid & 63, wr = wid >> 2, wc = wid & 3, fr = lane & 15, fq = lane >> 4;
    const int K = g.K, nt = K / BK;
    unsigned voffA[2], voffB[2];
#pragma unroll
    for (int i = 0; i < 2; ++i) { int R, C; stage_rc(tid * 16 + i * 8192, R, C); const int Rb = Epi::PERM ? ((R & ~31) + perm32(R & 31)) : R;
        voffA[i] = (unsigned)(R * g.lda + C) * 2u; voffB[i] = (unsigned)(Rb * g.ldb + C) * 2u; }
    const size_t kstep = (size_t)(BK * 2);
    const size_t hsA = (size_t)HALF * g.lda * 2, hsB = (size_t)HALF * g.ldb * 2;
    const size_t tsA = 2 * hsA, tsB = 2 * hsB;
    const unsigned ldsw = (unsigned)wid * 1024u;
    const int aoff = lds_byte(wr * 64 + fr, fq * 8), boff = lds_byte(wc * 32 + fr, fq * 8);
#define PG8_SA(b, h) (((b) * 2 + (h)) * HTB)
#define PG8_SB(b, h) ((4 + (b) * 2 + (h)) * HTB)
#define PG8_STAGE(bufoff, gbase, voff) do { _Pragma("unroll") for (int _i = 0; _i < 2; ++_i) \
        __builtin_amdgcn_global_load_lds((const unsigned*)((const char*)(gbase) + (voff)[_i]), (PG8_LAS unsigned*)(lds + (bufoff) + ldsw + _i * 8192), 16, 0, 0); } while (0)
#define PG8_LDA(dst, b, h) do { _Pragma("unroll") for (int m = 0; m < 4; ++m) _Pragma("unroll") for (int k = 0; k < 2; ++k) dst[m][k] = *(const PG8_LAS bf16x8*)(lds + PG8_SA(b, h) + aoff + m * 2048 + k * 1024); } while (0)
#define PG8_LDB(dst, b, h) do { _Pragma("unroll") for (int n = 0; n < 2; ++n) _Pragma("unroll") for (int k = 0; k < 2; ++k) dst[n][k] = *(const PG8_LAS bf16x8*)(lds + PG8_SB(b, h) + boff + n * 2048 + k * 1024); } while (0)
#define PG8_MMA(ai, bj, At, Bt) do { __builtin_amdgcn_s_setprio(1); _Pragma("unroll") for (int m = 0; m < 4; ++m) _Pragma("unroll") for (int n = 0; n < 2; ++n) _Pragma("unroll") for (int k = 0; k < 2; ++k) \
        acc[ai][bj][m][n] = __builtin_amdgcn_mfma_f32_16x16x32_bf16(Bt[n][k], At[m][k], acc[ai][bj][m][n], 0, 0, 0); __builtin_amdgcn_s_setprio(0); } while (0)
#define PG8_WAIT_V(n) asm volatile("s_waitcnt vmcnt(" #n ")" ::: "memory")
#define PG8_WAIT_L(n) asm volatile("s_waitcnt lgkmcnt(" #n ")" ::: "memory")
#define PG8_BAR __builtin_amdgcn_s_barrier()
#define PG8_SCHED __builtin_amdgcn_sched_barrier(0)
    Unit cur, nxt; int ui = 0;
    if (!S.next(0, cur)) return;
    f32x4 acc[2][2][4][2];
#pragma unroll
    for (int a = 0; a < 2; ++a)
#pragma unroll
        for (int b = 0; b < 2; ++b)
#pragma unroll
            for (int m = 0; m < 4; ++m)
#pragma unroll
                for (int n = 0; n < 2; ++n) acc[a][b][m][n] = (f32x4){0.f, 0.f, 0.f, 0.f};
    bf16x8 At[4][2], B0[2][2], B1[2][2];
    const char* cA = (const char*)g.A + (size_t)cur.pm * tsA; const char* cB = (const char*)g.Bt + (size_t)cur.pn * tsB;
    S.a_ready(cur);
    if constexpr (SP2) {
        PG8_STAGE(PG8_SB(0, 0), cB, voffB); PG8_STAGE(PG8_SB(0, 1), cB + hsB, voffB); PG8_STAGE(PG8_SA(0, 0), cA, voffA); PG8_STAGE(PG8_SA(0, 1), cA + hsA, voffA);
        if (wr == 1) PG8_BAR;
        PG8_WAIT_V(2); PG8_BAR;
        PG8_STAGE(PG8_SB(1, 0), cB + kstep, voffB); PG8_STAGE(PG8_SA(1, 0), cA + kstep, voffA); PG8_STAGE(PG8_SB(1, 1), cB + hsB + kstep, voffB);
        PG8_WAIT_V(6); PG8_BAR;
    } else {
        PG8_STAGE(PG8_SB(0, 0), cB, voffB); PG8_STAGE(PG8_SA(0, 0), cA, voffA); PG8_STAGE(PG8_SB(0, 1), cB + hsB, voffB); PG8_STAGE(PG8_SA(0, 1), cA + hsA, voffA);
        if (wr == 1) PG8_BAR;
        PG8_WAIT_V(4); PG8_BAR;
        PG8_STAGE(PG8_SB(1, 0), cB + kstep, voffB); PG8_STAGE(PG8_SA(1, 0), cA + kstep, voffA); PG8_STAGE(PG8_SB(1, 1), cB + hsB + kstep, voffB);
        PG8_WAIT_V(6); PG8_BAR;
    }
    for (;;) {
        const bool has_next = S.next(ui + 1, nxt);
        const char* nA = has_next ? (const char*)g.A + (size_t)nxt.pm * tsA : cA; const char* nB = has_next ? (const char*)g.Bt + (size_t)nxt.pn * tsB : cB;
        for (int t = 0; t < nt; t += 2) {
            const bool last = (t == nt - 2);
            const char* a1 = cA + (size_t)(t + 1) * kstep;
            const char* a2 = last ? nA : cA + (size_t)(t + 2) * kstep; const char* b2 = last ? nB : cB + (size_t)(t + 2) * kstep;
            const char* a3 = a2 + kstep; const char* b3 = b2 + kstep;
            if (last && has_next) S.a_ready(nxt);
            if constexpr (SP2) {
            PG8_LDB(B0, 0, 0); PG8_LDB(B1, 0, 1); PG8_SCHED; PG8_LDA(At, 0, 0); PG8_STAGE(PG8_SA(1, 1), a1 + hsA, voffA);
            PG8_WAIT_V(8); PG8_WAIT_L(0); PG8_BAR; PG8_MMA(0, 0, At, B0); PG8_MMA(0, 1, At, B1); PG8_BAR; PG8_SCHED;
            PG8_LDA(At, 0, 1); PG8_STAGE(PG8_SB(0, 0), b2, voffB); PG8_STAGE(PG8_SB(0, 1), b2 + hsB, voffB); PG8_STAGE(PG8_SA(0, 0), a2, voffA);
            PG8_WAIT_V(8); PG8_WAIT_L(0); PG8_BAR; PG8_MMA(1, 0, At, B0); PG8_MMA(1, 1, At, B1); PG8_BAR; PG8_SCHED;
            PG8_LDB(B0, 1, 0); PG8_LDB(B1, 1, 1); PG8_SCHED; PG8_LDA(At, 1, 0); PG8_STAGE(PG8_SA(0, 1), a2 + hsA, voffA);
            PG8_WAIT_V(8); PG8_WAIT_L(0); PG8_BAR; PG8_MMA(0, 0, At, B0); PG8_MMA(0, 1, At, B1); PG8_BAR; PG8_SCHED;
            PG8_LDA(At, 1, 1); PG8_STAGE(PG8_SB(1, 0), b3, voffB); PG8_STAGE(PG8_SB(1, 1), b3 + hsB, voffB); PG8_STAGE(PG8_SA(1, 0), a3, voffA);
            PG8_WAIT_V(8); PG8_WAIT_L(0); PG8_BAR; PG8_MMA(1, 0, At, B0); PG8_MMA(1, 1, At, B1); PG8_BAR; PG8_SCHED;
            } else {
            PG8_LDB(B0, 0, 0); PG8_SCHED; PG8_LDA(At, 0, 0); PG8_STAGE(PG8_SA(1, 1), a1 + hsA, voffA);
            PG8_WAIT_L(8); PG8_BAR; PG8_WAIT_L(0); PG8_MMA(0, 0, At, B0); PG8_BAR; PG8_SCHED;
            PG8_LDB(B1, 0, 1); PG8_STAGE(PG8_SB(0, 0), b2, voffB);
            PG8_BAR; PG8_WAIT_L(0); PG8_MMA(0, 1, At, B1); PG8_BAR;
            PG8_LDA(At, 0, 1); PG8_STAGE(PG8_SA(0, 0), a2, voffA);
            PG8_BAR; PG8_WAIT_L(0); PG8_MMA(1, 0, At, B0); PG8_BAR; PG8_SCHED;
            PG8_STAGE(PG8_SB(0, 1), b2 + hsB, voffB);
            PG8_WAIT_V(6); PG8_BAR; PG8_MMA(1, 1, At, B1); PG8_BAR;
            PG8_LDB(B0, 1, 0); PG8_SCHED; PG8_LDA(At, 1, 0); PG8_STAGE(PG8_SA(0, 1), a2 + hsA, voffA);
            PG8_WAIT_L(8); PG8_BAR; PG8_WAIT_L(0); PG8_MMA(0, 0, At, B0); PG8_BAR; PG8_SCHED;
            PG8_LDB(B1, 1, 1); PG8_STAGE(PG8_SB(1, 0), b3, voffB);
            PG8_BAR; PG8_WAIT_L(0); PG8_MMA(0, 1, At, B1); PG8_BAR;
            PG8_LDA(At, 1, 1); PG8_STAGE(PG8_SA(1, 0), a3, voffA);
            PG8_BAR; PG8_WAIT_L(0); PG8_MMA(1, 0, At, B0); PG8_BAR; PG8_SCHED;
            PG8_STAGE(PG8_SB(1, 1), b3 + hsB, voffB);
            PG8_WAIT_V(6); PG8_BAR; PG8_MMA(1, 1, At, B1); PG8_BAR;
            }
        }
        if constexpr (ALIGN_EPI) { if (wr == 0) PG8_BAR; }
        if constexpr (!Epi::AFTER_DRAIN) { E(acc, cur, wr, wc, fr, fq); S.done(cur); }
        if (!has_next) break;
#pragma unroll
        for (int a = 0; a < 2; ++a)
#pragma unroll
            for (int b = 0; b < 2; ++b)
#pragma unroll
                for (int m = 0; m < 4; ++m)
#pragma unroll
                    for (int n = 0; n < 2; ++n) acc[a][b][m][n] = (f32x4){0.f, 0.f, 0.f, 0.f};
        cur = nxt; cA = nA; cB = nB; ++ui;
        if constexpr (ALIGN_EPI) { if (wr == 1) PG8_BAR; }
    }
    PG8_WAIT_V(0);
    if constexpr (!ALIGN_EPI) { if (wr == 0) PG8_BAR; }
    PG8_BAR;
    if constexpr (Epi::AFTER_DRAIN) { E.fused(acc, cur, wr, wc, fr, fq, lds, wid, lane); S.done(cur); }
#undef PG8_SA
#undef PG8_SB
#undef PG8_STAGE
#undef PG8_LDA
#undef PG8_LDB
#undef PG8_MMA
#undef PG8_WAIT_V
#undef PG8_WAIT_L
#undef PG8_BAR
#undef PG8_SCHED
}
}

using pg8::bf16_t; using pg8::bf16x8; using pg8::f32x4; using pg8::u32x4; using pg8::Unit; using pg8::cvt_pk_bf16;
#define LAS __attribute__((address_space(3)))
typedef float f32x16 __attribute__((ext_vector_type(16)));
typedef unsigned u32x2 __attribute__((ext_vector_type(2)));
constexpr int M = 32768, SEQ = 4096, DM = 1024;
constexpr int NZ = 4352;
constexpr int OKV = 384, OKR = 640, OGA = 672, OU = 1184, OGP = 1696, OGMA = 2208, OGMP = 3232;
constexpr float EPS = 1e-6f;
constexpr float LOG2E = 1.4426950408889634f;
constexpr float C2 = 0.10206207261596577f * 1.4426950408889634f;
constexpr size_t MiB = 1u << 20;
constexpr size_t WS_SSQ = 0;
constexpr size_t WS_BAR = 384 * 1024;
constexpr size_t WS_CS = 512 * 1024;
constexpr size_t WS_WIN = 1 * MiB, WS_WQ = 10 * MiB, WS_WK = 11 * MiB, WS_WV = 11 * MiB + 512 * 1024, WS_WBD = 12 * MiB, WS_WA = 13 * MiB, WS_WP = 14 * MiB, WS_WO = 15 * MiB;
constexpr size_t WS_R64 = 18 * MiB;
constexpr size_t WS_Z = 82 * MiB;
constexpr size_t WS_YA = 354 * MiB, WS_YP = 386 * MiB, WS_MG = 418 * MiB, WS_END = 482 * MiB;
constexpr size_t DO_Q = 0, DO_KN = 48 * MiB, DO_VT = 80 * MiB, DO_KR = 112 * MiB;

__device__ __forceinline__ float ex2(float x) { return __builtin_amdgcn_exp2f(x); }
__device__ __forceinline__ float rcpf_(float x) { return __builtin_amdgcn_rcpf(x); }
__device__ __forceinline__ float sigmoidf_(float x) { return rcpf_(1.f + ex2(-x * LOG2E)); }
__device__ __forceinline__ float siluf_(float x) { return x * sigmoidf_(x); }
__device__ __forceinline__ void unpack8(u32x4 w, float (&f)[8]) {
    f[0] = __uint_as_float(w.x << 16); f[1] = __uint_as_float(w.x & 0xffff0000u); f[2] = __uint_as_float(w.y << 16); f[3] = __uint_as_float(w.y & 0xffff0000u);
    f[4] = __uint_as_float(w.z << 16); f[5] = __uint_as_float(w.z & 0xffff0000u); f[6] = __uint_as_float(w.w << 16); f[7] = __uint_as_float(w.w & 0xffff0000u);
}
__device__ __forceinline__ u32x4 pack8(const float (&f)[8]) { u32x4 w; w.x = cvt_pk_bf16(f[0], f[1]); w.y = cvt_pk_bf16(f[2], f[3]); w.z = cvt_pk_bf16(f[4], f[5]); w.w = cvt_pk_bf16(f[6], f[7]); return w; }

#define EPI_LOOP_BEGIN(ldc_) \
    int fr_ = fr, fq_ = fq; asm volatile("" : "+v"(fr_), "+v"(fq_));     \
    const int row0 = u.pm * pg8::BM + wr * 64 + fr_; const int col0 = u.pn * pg8::BM + wc * 32 + 8 * fq_; \
    _Pragma("unroll") for (int ai = 0; ai < 2; ++ai) _Pragma("unroll") for (int m = 0; m < 4; ++m) { const int row = row0 + ai * pg8::HALF + m * 16; \
    _Pragma("unroll") for (int bj = 0; bj < 2; ++bj) { const int col = col0 + bj * pg8::HALF; \
        float v[8] = {acc[ai][bj][m][0][0], acc[ai][bj][m][0][1], acc[ai][bj][m][0][2], acc[ai][bj][m][0][3], acc[ai][bj][m][1][0], acc[ai][bj][m][1][1], acc[ai][bj][m][1][2], acc[ai][bj][m][1][3]};
#define EPI_LOOP_END } asm volatile("" ::: "memory"); }

struct EpiZ { static constexpr bool PERM = true, AFTER_DRAIN = false;
    bf16_t* O;
    __device__ __forceinline__ void operator()(const f32x4 (&acc)[2][2][4][2], const Unit& u, int wr, int wc, int fr, int fq) const {
        EPI_LOOP_BEGIN(NZ)
            *(u32x4*)(O + (size_t)row * NZ + col) = pack8(v);
        EPI_LOOP_END
    }
};
struct EpiRowScale { static constexpr bool PERM = true, AFTER_DRAIN = false;
    bf16_t* O; const float* rstd; int ldc; float mul;
    __device__ __forceinline__ void operator()(const f32x4 (&acc)[2][2][4][2], const Unit& u, int wr, int wc, int fr, int fq) const {
        EPI_LOOP_BEGIN(ldc)
            const float sc = rstd[row] * mul;
#pragma unroll
            for (int j = 0; j < 8; ++j) v[j] *= sc;
            *(u32x4*)(O + (size_t)row * ldc + col) = pack8(v);
        EPI_LOOP_END
    }
};
struct EpiVT { static constexpr bool PERM = true, AFTER_DRAIN = false;
    bf16_t* O; const float* rstd;
    __device__ __forceinline__ void operator()(const f32x4 (&acc)[2][2][4][2], const Unit& u, int wr, int wc, int fr, int fq) const {
        EPI_LOOP_BEGIN(M)
            const f32x4 q0 = *(const f32x4*)(rstd + col), q1 = *(const f32x4*)(rstd + col + 4);
            const float qq[8] = {q0[0], q0[1], q0[2], q0[3], q1[0], q1[1], q1[2], q1[3]};
#pragma unroll
            for (int j = 0; j < 8; ++j) v[j] *= qq[j];
            *(u32x4*)(O + (size_t)row * M + col) = pack8(v);
        EPI_LOOP_END
    }
};
struct EpiPool { static constexpr bool PERM = true, AFTER_DRAIN = false;
    bf16_t* O; const bf16_t* Z;
    __device__ __forceinline__ void operator()(const f32x4 (&acc)[2][2][4][2], const Unit& u, int wr, int wc, int fr, int fq) const {
        EPI_LOOP_BEGIN(512)
            float g[8]; unpack8(*(const u32x4*)(Z + (size_t)row * NZ + OGP + col), g);
#pragma unroll
            for (int j = 0; j < 8; ++j) v[j] *= siluf_(g[j]);
            *(u32x4*)(O + (size_t)row * 512 + col) = pack8(v);
        EPI_LOOP_END
    }
};
template <bool ADD> struct EpiMerge { static constexpr bool PERM = true, AFTER_DRAIN = false;
    bf16_t* O; const bf16_t* Z; const bf16_t* T; int og;
    __device__ __forceinline__ void operator()(const f32x4 (&acc)[2][2][4][2], const Unit& u, int wr, int wc, int fr, int fq) const {
        EPI_LOOP_BEGIN(1024)
            float g[8]; unpack8(*(const u32x4*)(Z + (size_t)row * NZ + og + col), g);
            float tt[8];
            if (ADD) unpack8(*(const u32x4*)(T + (size_t)row * 1024 + col), tt);
#pragma unroll
            for (int j = 0; j < 8; ++j) { v[j] *= sigmoidf_(g[j]); if (ADD) v[j] += tt[j]; }
            *(u32x4*)(O + (size_t)row * 1024 + col) = pack8(v);
        EPI_LOOP_END
    }
};
struct EpiOut { static constexpr bool PERM = true, AFTER_DRAIN = false;
    const float* X; float* O;
    __device__ __forceinline__ void operator()(const f32x4 (&acc)[2][2][4][2], const Unit& u, int wr, int wc, int fr, int fq) const {
        EPI_LOOP_BEGIN(1024)
            const f32x4 x0 = *(const f32x4*)(X + (size_t)row * 1024 + col), x1 = *(const f32x4*)(X + (size_t)row * 1024 + col + 4);
            f32x4 h0 = {v[0] + x0[0], v[1] + x0[1], v[2] + x0[2], v[3] + x0[3]}, h1 = {v[4] + x1[0], v[5] + x1[1], v[6] + x1[2], v[7] + x1[3]};
            *(f32x4*)(O + (size_t)row * 1024 + col) = h0; *(f32x4*)(O + (size_t)row * 1024 + col + 4) = h1;
        EPI_LOOP_END
    }
};

namespace att {
constexpr int KPB = 208, VPB = 136;
constexpr int KBYTES = 64 * KPB, VBYTES = 64 * VPB, BUFB = KBYTES + VBYTES;
__device__ __forceinline__ bf16x8 pk8(const f32x16& p, int b) {
    u32x4 w; w.x = cvt_pk_bf16(p[b], p[b + 1]); w.y = cvt_pk_bf16(p[b + 2], p[b + 3]); w.z = cvt_pk_bf16(p[b + 4], p[b + 5]); w.w = cvt_pk_bf16(p[b + 6], p[b + 7]);
    return __builtin_bit_cast(bf16x8, w);
}
__device__ __forceinline__ void attn_unit(int b, int h, int qb, const bf16_t* __restrict__ Q, const bf16_t* __restrict__ KN, const bf16_t* __restrict__ KR, const bf16_t* __restrict__ VT,
                                          const bf16_t* __restrict__ Z, const float* __restrict__ cs, bf16_t* __restrict__ YA, LAS unsigned char* lds, const int wave_s) {
    int tid = wave_s * 64 + mk_lane_id(); asm volatile("" : "+v"(tid));
    const int lane = tid & 63, r32 = lane & 31, hi = lane >> 5;
    const int wid = __builtin_amdgcn_readfirstlane(tid >> 6);
    const size_t rowbase = (size_t)b * SEQ;
    const int q0 = qb * 256, myq = q0 + wid * 32 + r32, cw = (q0 + wid * 32) >> 6, NT = (q0 + 256) >> 6;
    bf16x8 qr[6];
    { const bf16_t* qp = Q + (rowbase + myq) * 768 + h * 96 + 8 * hi;
#pragma unroll
      for (int s = 0; s < 6; ++s) qr[s] = *(const bf16x8*)(qp + 16 * s);
      float x1[8], x2[8], r1[8], r2[8]; unpack8(__builtin_bit_cast(u32x4, qr[4]), x1); unpack8(__builtin_bit_cast(u32x4, qr[5]), x2);
      const float* c = cs + (size_t)myq * 32 + 8 * hi;
#pragma unroll
      for (int e = 0; e < 8; ++e) { const float cc = c[e], sn = c[16 + e]; r1[e] = x1[e] * cc - x2[e] * sn; r2[e] = x1[e] * sn + x2[e] * cc; }
      qr[4] = __builtin_bit_cast(bf16x8, pack8(r1)); qr[5] = __builtin_bit_cast(bf16x8, pack8(r2)); }
    const int kr_ = tid >> 3, kc_ = tid & 7, rr_ = (tid & 255) >> 2, rc_ = tid & 3;
    const bf16_t* kn_src = KN + (rowbase + kr_) * 512 + h * 64 + kc_ * 8;
    const bf16_t* kr_src = KR + (rowbase + rr_) * 32 + rc_ * 8;
    const bf16_t* vt_src = VT + (size_t)(h * 64 + kr_) * M + rowbase + kc_ * 8;
    const unsigned kn_dst = kr_ * KPB + kc_ * 16, kr_dst = rr_ * KPB + 128 + rc_ * 16, vt_dst = KBYTES + kr_ * VPB + kc_ * 16;
    const bool has_r = tid < 256;
    u32x4 sk, sr = {0u, 0u, 0u, 0u}, sv;
    sk = *(const u32x4*)kn_src; if (has_r) sr = *(const u32x4*)kr_src; sv = *(const u32x4*)vt_src;
    *(LAS u32x4*)(lds + kn_dst) = sk; if (has_r) *(LAS u32x4*)(lds + kr_dst) = sr;
    *(LAS u32x2*)(lds + vt_dst) = (u32x2){sv.x, sv.y}; *(LAS u32x2*)(lds + vt_dst + 8) = (u32x2){sv.z, sv.w};
    __syncthreads();
    float mref = -INFINITY, lsum = 0.f;
    f32x16 o0, o1;
#pragma unroll
    for (int r = 0; r < 16; ++r) { o0[r] = 0.f; o1[r] = 0.f; }
    for (int t = 0; t < NT; ++t) {
        const bool more = (t + 1 < NT);
        if (more) { sk = *(const u32x4*)(kn_src + (size_t)(t + 1) * 64 * 512); if (has_r) sr = *(const u32x4*)(kr_src + (size_t)(t + 1) * 64 * 32); sv = *(const u32x4*)(vt_src + (size_t)(t + 1) * 64); }
        if (t <= cw) {
            LAS const unsigned char* buf = lds + (t & 1) * BUFB;
            LAS const unsigned char* kb = buf + r32 * KPB + hi * 16;
            f32x16 p0, p1;
#pragma unroll
            for (int r = 0; r < 16; ++r) { p0[r] = 0.f; p1[r] = 0.f; }
#pragma unroll
            for (int s = 0; s < 6; ++s) {
                const bf16x8 a0 = *(LAS const bf16x8*)(kb + s * 32), a1 = *(LAS const bf16x8*)(kb + 32 * KPB + s * 32);
                p0 = __builtin_amdgcn_mfma_f32_32x32x16_bf16(a0, qr[s], p0, 0, 0, 0);
                p1 = __builtin_amdgcn_mfma_f32_32x32x16_bf16(a1, qr[s], p1, 0, 0, 0);
            }
            float rm = fmaxf(p0[0], p1[0]);
#pragma unroll
            for (int r = 1; r < 16; ++r) rm = fmaxf(rm, fmaxf(p0[r], p1[r]));
            rm = fmaxf(rm, __shfl_xor(rm, 32));
            if (__any(rm > mref + 8.f)) {
                const float mn = fmaxf(mref, rm), al = ex2(mref - mn);
                lsum *= al;
#pragma unroll
                for (int r = 0; r < 16; ++r) { o0[r] *= al; o1[r] *= al; }
                mref = mn;
            }
            float ls = 0.f;
#pragma unroll
            for (int r = 0; r < 16; ++r) { p0[r] = ex2(p0[r] - mref); p1[r] = ex2(p1[r] - mref); ls += p0[r] + p1[r]; }
            lsum += ls;
            bf16x8 pf[4]; pf[0] = pk8(p0, 0); pf[1] = pk8(p0, 8); pf[2] = pk8(p1, 0); pf[3] = pk8(p1, 8);
            LAS const unsigned char* vb = buf + KBYTES + r32 * VPB + hi * 8;
#pragma unroll
            for (int i = 0; i < 4; ++i) {
                const u32x2 a = *(LAS const u32x2*)(vb + i * 32), c = *(LAS const u32x2*)(vb + i * 32 + 16);
                const u32x2 a2 = *(LAS const u32x2*)(vb + 32 * VPB + i * 32), c2 = *(LAS const u32x2*)(vb + 32 * VPB + i * 32 + 16);
                o0 = __builtin_amdgcn_mfma_f32_32x32x16_bf16(__builtin_bit_cast(bf16x8, (u32x4){a.x, a.y, c.x, c.y}), pf[i], o0, 0, 0, 0);
                o1 = __builtin_amdgcn_mfma_f32_32x32x16_bf16(__builtin_bit_cast(bf16x8, (u32x4){a2.x, a2.y, c2.x, c2.y}), pf[i], o1, 0, 0, 0);
            }
        }
        if (more) { LAS unsigned char* nb = lds + ((t + 1) & 1) * BUFB;
            *(LAS u32x4*)(nb + kn_dst) = sk; if (has_r) *(LAS u32x4*)(nb + kr_dst) = sr;
            *(LAS u32x2*)(nb + vt_dst) = (u32x2){sv.x, sv.y}; *(LAS u32x2*)(nb + vt_dst + 8) = (u32x2){sv.z, sv.w}; }
        __syncthreads();
    }
    const float inv = rcpf_(lsum + __shfl_xor(lsum, 32));
    bf16_t* yp = YA + (rowbase + myq) * 512 + h * 64 + 4 * hi;
    const bf16_t* gp = Z + (rowbase + myq) * NZ + OGA + h * 64 + 4 * hi;
#pragma unroll
    for (int db = 0; db < 2; ++db)
#pragma unroll
        for (int g4 = 0; g4 < 4; ++g4) {
            const u32x2 gw = *(const u32x2*)(gp + 32 * db + 8 * g4);
            const float g0 = __uint_as_float(gw.x << 16), g1 = __uint_as_float(gw.x & 0xffff0000u), g2 = __uint_as_float(gw.y << 16), g3 = __uint_as_float(gw.y & 0xffff0000u);
            const f32x16& o = db ? o1 : o0;
            u32x2 w; w.x = cvt_pk_bf16(o[4 * g4] * inv * siluf_(g0), o[4 * g4 + 1] * inv * siluf_(g1)); w.y = cvt_pk_bf16(o[4 * g4 + 2] * inv * siluf_(g2), o[4 * g4 + 3] * inv * siluf_(g3));
            *(u32x2*)(yp + 32 * db + 8 * g4) = w;
        }
}
}

typedef unsigned v4u __attribute__((ext_vector_type(4)));
__device__ __forceinline__ float wave_sum(float v) {
#pragma unroll
    for (int o = 1; o < 64; o <<= 1) v += __shfl_xor(v, o);
    return v;
}
__device__ __forceinline__ void transpose_item(const float* __restrict__ W, int N, bf16_t* dst, int ldk, const float* kscale, LAS float* scr, int k0, int n0, int lane) {
#pragma unroll 8
    for (int i = 0; i < 32; ++i) { const int kk = 2 * i + (lane >> 5); const float s = kscale ? kscale[k0 + kk] : 1.f; scr[kk * 33 + (lane & 31)] = W[(size_t)(k0 + kk) * N + n0 + (lane & 31)] * s; }
    asm volatile("s_waitcnt lgkmcnt(0)" ::: "memory");
    const int c = lane & 7;
#pragma unroll
    for (int j = 0; j < 4; ++j) { const int n = (lane >> 3) + 8 * j; const LAS float* s = scr + (8 * c) * 33 + n;
        v4u o; o.x = cvt_pk_bf16(s[0 * 33], s[1 * 33]); o.y = cvt_pk_bf16(s[2 * 33], s[3 * 33]); o.z = cvt_pk_bf16(s[4 * 33], s[5 * 33]); o.w = cvt_pk_bf16(s[6 * 33], s[7 * 33]);
        *(v4u*)(dst + (size_t)n * ldk + k0 + 8 * c) = o; }
    asm volatile("s_waitcnt lgkmcnt(0)" ::: "memory");
}

struct Args { const float* in[13]; float* out; unsigned char* ws; int ph_lo, ph_hi; };
constexpr int NWAVES = 8, NTHR = 512;
constexpr int LDS_BYTES = 135168;

__global__ void __launch_bounds__(NTHR, 2) mk_fwd(Args a) {
    extern __shared__ __attribute__((aligned(16))) unsigned char lds_raw[];
    LAS unsigned char* lds = (LAS unsigned char*)lds_raw;
    cg::grid_group grid = cg::this_grid();
    const int wave_s = __builtin_amdgcn_readfirstlane(threadIdx.x >> 6);
    const int G = gridDim.x, bx = blockIdx.x;
    const int vcu = (G % 8 == 0) ? (bx % 8) * (G / 8) + bx / 8 : bx;
    const int NGW = G * NWAVES, NGT = G * NTHR;
#define PHASE_IDS int tid = wave_s * 64 + mk_lane_id(); asm volatile("" : "+v"(tid)); const int lane = tid & 63, wave = __builtin_amdgcn_readfirstlane(tid >> 6), gw = vcu * NWAVES + wave, gtid = vcu * NTHR + tid; (void)lane; (void)gw; (void)gtid;
    const float* x = a.in[0]; const float* norm_in = a.in[1]; const float* w_in = a.in[2]; const float* q_norm = a.in[3]; const float* w_uq = a.in[4];
    const float* kv_norm = a.in[5]; const float* w_ukv = a.in[6]; const float* pool_w = a.in[7]; const float* pool_scale = a.in[8];
    const float* w_ba = a.in[9]; const float* w_bp = a.in[10]; const float* w_out = a.in[11]; const float* norm_final = a.in[12];
    unsigned char* ws = a.ws; unsigned char* dob = (unsigned char*)a.out;
    float* rstd_q = (float*)(ws + WS_SSQ); float* rstd_kv = rstd_q + M; float* cs = (float*)(ws + WS_CS);
    bf16_t* WinT = (bf16_t*)(ws + WS_WIN); bf16_t* WqT = (bf16_t*)(ws + WS_WQ); bf16_t* WkT = (bf16_t*)(ws + WS_WK); bf16_t* WvT = (bf16_t*)(ws + WS_WV);
    bf16_t* WbdT = (bf16_t*)(ws + WS_WBD); bf16_t* WaT = (bf16_t*)(ws + WS_WA); bf16_t* WpT = (bf16_t*)(ws + WS_WP); bf16_t* WoT = (bf16_t*)(ws + WS_WO);
    bf16_t* XN = (bf16_t*)(ws + WS_R64); bf16_t* DP = XN; bf16_t* TT = XN;
    bf16_t* Z = (bf16_t*)(ws + WS_Z); bf16_t* YA = (bf16_t*)(ws + WS_YA); bf16_t* YP = (bf16_t*)(ws + WS_YP); bf16_t* MG = (bf16_t*)(ws + WS_MG);
    bf16_t* Qb = (bf16_t*)(dob + DO_Q); bf16_t* KN = (bf16_t*)(dob + DO_KN); bf16_t* VT = (bf16_t*)(dob + DO_VT); bf16_t* KR = (bf16_t*)(dob + DO_KR);
    const int lo = a.ph_lo, hi_ = a.ph_hi;
#define IN(k) (lo <= (k) && (k) < hi_)
    unsigned* bar_ctr = (unsigned*)(ws + WS_BAR);
#define SEAM(k) do { if (IN(k) && IN((k) + 1)) { asm volatile("s_waitcnt vmcnt(0)" ::: "memory"); __syncthreads(); \
        if ((k) == 0) grid.sync(); \
        else { if (wave_s == 0 && mk_lane_id() == 0) { __builtin_amdgcn_fence(__ATOMIC_RELEASE, "agent"); asm volatile("s_waitcnt vmcnt(0)" ::: "memory"); \
                   __hip_atomic_fetch_add(bar_ctr, 1u, __ATOMIC_RELAXED, __HIP_MEMORY_SCOPE_AGENT); unsigned sp_ = 0; \
                   while (__hip_atomic_load(bar_ctr, __ATOMIC_RELAXED, __HIP_MEMORY_SCOPE_AGENT) < (unsigned)G * (unsigned)(k) && ++sp_ < (1u << 24)) __builtin_amdgcn_s_sleep(2); } \
               __syncthreads(); } \
        __builtin_amdgcn_fence(__ATOMIC_ACQUIRE, "agent"); asm volatile("s_waitcnt vmcnt(0)" ::: "memory"); __syncthreads(); } } while (0)
    if (IN(0)) { PHASE_IDS
        LAS float* scr = (LAS float*)(lds + wave * 16384);
        constexpr int I_IN = 16 * 133, I_Q = 6 * 24, I_KV = 4 * 32, I_A = 8 * 32, I_P = 8 * 32, I_O = 16 * 32, NITEMS = I_IN + I_Q + I_KV + I_A + I_P + I_O;
        for (int it = gw; it < NITEMS; it += NGW) {
            int r = it;
            if (r < I_IN) { const int kb = r / 133, nb = r % 133; transpose_item(w_in, 4256, WinT + (size_t)(32 * nb) * 1024, 1024, nullptr, scr, 64 * kb, 32 * nb, lane); continue; } r -= I_IN;
            if (r < I_Q) { const int kb = r / 24, nb = r % 24; transpose_item(w_uq, 768, WqT + (size_t)(32 * nb) * 384, 384, q_norm, scr, 64 * kb, 32 * nb, lane); continue; } r -= I_Q;
            if (r < I_KV) { const int kb = r / 32, nb = r % 32; const int n0 = 32 * nb, hh = n0 >> 7, j0 = n0 & 127;
                bf16_t* dst = (j0 < 64) ? WkT + (size_t)(64 * hh + j0) * 256 : WvT + (size_t)(64 * hh + j0 - 64) * 256;
                transpose_item(w_ukv, 1024, dst, 256, kv_norm, scr, 64 * kb, n0, lane); continue; } r -= I_KV;
            if (r < I_A) { const int kb = r / 32, nb = r % 32; transpose_item(w_ba, 1024, WaT + (size_t)(32 * nb) * 512, 512, nullptr, scr, 64 * kb, 32 * nb, lane); continue; } r -= I_A;
            if (r < I_P) { const int kb = r / 32, nb = r % 32; transpose_item(w_bp, 1024, WpT + (size_t)(32 * nb) * 512, 512, nullptr, scr, 64 * kb, 32 * nb, lane); continue; } r -= I_P;
            { const int kb = r / 32, nb = r % 32; transpose_item(w_out, 1024, WoT + (size_t)(32 * nb) * 1024, 1024, nullptr, scr, 64 * kb, 32 * nb, lane); }
        }
        for (int i = gtid; i < 12288; i += NGT) ((v4u*)(WinT + (size_t)4256 * 1024))[i] = (v4u){0u, 0u, 0u, 0u};
        for (int i = gtid; i < 512 * 256; i += NGT) { const int n = i >> 8, k = (i & 255) * 2; float v0 = 0.f, v1 = 0.f;
            if ((k >> 7) == (n >> 7)) { const float sc = pool_scale[n]; const float* p = pool_w + (size_t)(n >> 7) * 16384 + (size_t)(k & 127) * 128 + (n & 127); v0 = p[0] * sc; v1 = p[128] * sc; }
            ((unsigned*)WbdT)[i] = cvt_pk_bf16(v0, v1); }
        for (int i = gtid; i < SEQ * 16; i += NGT) { const int s = i >> 4, f = i & 15;
            const float inv_freq = exp2f(-(float)f * 0.83048202372184059f);
            const float ang = (float)s * inv_freq;
            const double rev = (double)ang * 0.15915494309189535; const float fr_ = (float)(rev - rint(rev));
            cs[s * 32 + f] = __builtin_amdgcn_cosf(fr_); cs[s * 32 + 16 + f] = __builtin_amdgcn_sinf(fr_); }
        for (int m = gw; m < M; m += NGW) {
            const f32x4* xr = (const f32x4*)(x + (size_t)m * DM) + lane; const f32x4* gr = (const f32x4*)norm_in + lane;
            f32x4 v[4]; float s = 0.f;
#pragma unroll
            for (int j = 0; j < 4; ++j) { v[j] = xr[64 * j]; s += (v[j][0] * v[j][0] + v[j][1] * v[j][1]) + (v[j][2] * v[j][2] + v[j][3] * v[j][3]); }
            const float rstd = rsqrtf(wave_sum(s) * (1.f / DM) + EPS);
            u32x2* o8 = (u32x2*)(XN + (size_t)m * DM) + lane;
#pragma unroll
            for (int j = 0; j < 4; ++j) { const f32x4 g = gr[64 * j]; u32x2 w; w.x = cvt_pk_bf16(v[j][0] * rstd * g[0], v[j][1] * rstd * g[1]); w.y = cvt_pk_bf16(v[j][2] * rstd * g[2], v[j][3] * rstd * g[3]); o8[64 * j] = w; }
        }
        __syncthreads();
    }
    SEAM(0);
    if (IN(1)) {
        pg8::Gemm g{XN, WinT, M, NZ, 1024, 1024, 1024}; pg8::StaticOrder S; S.init(M, NZ, G, bx);
        EpiZ E{Z};
        pg8::gemm_phase<EpiZ, pg8::StaticOrder, true, true>(lds, g, S, E, wave_s);
    }
    SEAM(1);
    if (IN(2)) { PHASE_IDS
        for (int m = gw; m < M; m += NGW) {
            const bf16_t* zr = Z + (size_t)m * NZ; float f[8], sq = 0.f, sk = 0.f;
            unpack8(*(const u32x4*)(zr + 8 * lane), f); float s0 = 0.f;
#pragma unroll
            for (int e = 0; e < 8; ++e) s0 += f[e] * f[e];
            if (lane < 48) sq = s0; else sk = s0;
            if (lane < 16) { unpack8(*(const u32x4*)(zr + 512 + 8 * lane), f);
#pragma unroll
                for (int e = 0; e < 8; ++e) sk += f[e] * f[e]; }
            sq = wave_sum(sq); sk = wave_sum(sk);
            if (lane == 0) { rstd_q[m] = rsqrtf(sq * (1.f / 384.f) + EPS); rstd_kv[m] = rsqrtf(sk * (1.f / 256.f) + EPS); }
        }
        for (int i = gtid; i < (M / 16) * 64; i += NGT) {
            const int ch = i & 63, rb = i >> 6, c0 = 8 * ch, w = 2 << (c0 >> 7), rg0 = 16 * rb, t0 = rg0 & (SEQ - 1);
            const bf16_t* up = Z + (size_t)rg0 * NZ + OU + c0; bf16_t* dp = DP + (size_t)rg0 * 512 + c0;
            float sum[8] = {0.f, 0.f, 0.f, 0.f, 0.f, 0.f, 0.f, 0.f};
            for (int j = 1; j < w; ++j) if (t0 - j >= 0) { float f[8]; unpack8(*(const u32x4*)(up - (ptrdiff_t)j * NZ), f);
#pragma unroll
                for (int e = 0; e < 8; ++e) sum[e] += f[e]; }
            for (int r = 0; r < 16; ++r) { const int t = t0 + r; float cur[8]; unpack8(*(const u32x4*)(up + (size_t)r * NZ), cur);
                const float ic = 1.f / (float)min(t + 1, w); float o[8];
#pragma unroll
                for (int e = 0; e < 8; ++e) { sum[e] += cur[e]; o[e] = sum[e] * ic - cur[e]; }
                *(u32x4*)(dp + (size_t)r * 512) = pack8(o);
                if (t - w + 1 >= 0) { float f[8]; unpack8(*(const u32x4*)(up + (ptrdiff_t)(r - w + 1) * NZ), f);
#pragma unroll
                    for (int e = 0; e < 8; ++e) sum[e] -= f[e]; } }
        }
        for (int i = gtid; i < M * 2; i += NGT) { const int row = i >> 1, i0 = 8 * (i & 1), s = row & (SEQ - 1);
            float x1[8], x2[8]; unpack8(*(const u32x4*)(Z + (size_t)row * NZ + OKR + i0), x1); unpack8(*(const u32x4*)(Z + (size_t)row * NZ + OKR + 16 + i0), x2);
            const float* c = cs + s * 32 + i0; float o1[8], o2[8];
#pragma unroll
            for (int e = 0; e < 8; ++e) { const float cc = c[e], sn = c[16 + e]; o1[e] = x1[e] * cc - x2[e] * sn; o2[e] = x1[e] * sn + x2[e] * cc; }
            *(u32x4*)(KR + (size_t)row * 32 + i0) = pack8(o1); *(u32x4*)(KR + (size_t)row * 32 + 16 + i0) = pack8(o2); }
    }
    SEAM(2);
    if (IN(3)) {
        { pg8::Gemm g{Z, WqT, M, 768, 384, NZ, 384}; pg8::StaticOrder S; S.init(M, 768, G, bx); EpiRowScale E{Qb, rstd_q, 768, C2};
          pg8::gemm_phase<EpiRowScale, pg8::StaticOrder, true, true>(lds, g, S, E, wave_s); }
        { pg8::Gemm g{Z + OKV, WkT, M, 512, 256, NZ, 256}; pg8::StaticOrder S; S.init(M, 512, G, bx); EpiRowScale E{KN, rstd_kv, 512, 1.f};
          pg8::gemm_phase<EpiRowScale, pg8::StaticOrder, true, true>(lds, g, S, E, wave_s); }
        { pg8::Gemm g{WvT, Z + OKV, 512, M, 256, 256, NZ}; pg8::StaticOrder S; S.init(512, M, G, bx); EpiVT E{VT, rstd_kv};
          pg8::gemm_phase<EpiVT, pg8::StaticOrder, true, true>(lds, g, S, E, wave_s); }
        { pg8::Gemm g{DP, WbdT, M, 512, 512, 512, 512}; pg8::StaticOrder S; S.init(M, 512, G, bx); EpiPool E{YP, Z};
          pg8::gemm_phase<EpiPool, pg8::StaticOrder, true, true>(lds, g, S, E, wave_s); }
    }
    SEAM(3);
    if (IN(4)) {
        for (int v = vcu; v < 256; v += G) { const int bh = v >> 2, j = v & 3;
#pragma unroll 1
            for (int i = 0; i < 4; ++i) { const int qb = (i == 0) ? 15 - j : (i == 1) ? 8 + j : (i == 2) ? 7 - j : j;
                att::attn_unit(bh >> 3, bh & 7, qb, Qb, KN, KR, VT, Z, cs, YA, lds, wave_s); } }
    }
    SEAM(4);
    if (IN(5)) {
        { pg8::Gemm g{YA, WaT, M, 1024, 512, 512, 512}; pg8::StaticOrder S; S.init(M, 1024, G, bx); EpiMerge<false> E{TT, Z, nullptr, OGMA};
          pg8::gemm_phase<EpiMerge<false>, pg8::StaticOrder, true, true>(lds, g, S, E, wave_s); }
        asm volatile("s_waitcnt vmcnt(0)" ::: "memory"); __syncthreads();
        __builtin_amdgcn_fence(__ATOMIC_RELEASE, "agent"); __builtin_amdgcn_fence(__ATOMIC_ACQUIRE, "agent"); asm volatile("s_waitcnt vmcnt(0)" ::: "memory"); __syncthreads();
        { pg8::Gemm g{YP, WpT, M, 1024, 512, 512, 512}; pg8::StaticOrder S; S.init(M, 1024, G, bx); EpiMerge<true> E{MG, Z, TT, OGMP};
          pg8::gemm_phase<EpiMerge<true>, pg8::StaticOrder, true, true>(lds, g, S, E, wave_s); }
    }
    SEAM(5);
    if (IN(6)) {
        pg8::Gemm g{MG, WoT, M, 1024, 1024, 1024, 1024}; pg8::StaticOrder S; S.init(M, 1024, G, bx); EpiOut E{x, a.out};
        pg8::gemm_phase<EpiOut, pg8::StaticOrder, true, true>(lds, g, S, E, wave_s);
    }
    SEAM(6);
    if (IN(7)) { PHASE_IDS
        for (int m = gw; m < M; m += NGW) {
            f32x4* xr = (f32x4*)(a.out + (size_t)m * DM) + lane; const f32x4* gr = (const f32x4*)norm_final + lane;
            f32x4 v[4]; float s = 0.f;
#pragma unroll
            for (int j = 0; j < 4; ++j) { v[j] = xr[64 * j]; s += (v[j][0] * v[j][0] + v[j][1] * v[j][1]) + (v[j][2] * v[j][2] + v[j][3] * v[j][3]); }
            const float rstd = rsqrtf(wave_sum(s) * (1.f / DM) + EPS);
#pragma unroll
            for (int j = 0; j < 4; ++j) { const f32x4 g = gr[64 * j]; f32x4 o = {v[j][0] * rstd * g[0], v[j][1] * rstd * g[1], v[j][2] * rstd * g[2], v[j][3] * rstd * g[3]}; xr[64 * j] = o; }
        }
    }
#undef IN
#undef SEAM
}

#ifndef MK_N_LAUNCHES
#define MK_N_LAUNCHES 1
#endif
extern "C" void kernel_launch(void* const* d_in, const int* in_sizes, int n_in, void* d_out, int out_size, void* d_ws, size_t ws_size, hipStream_t stream) {
    static int grid = 0;
    if (grid == 0) {
        if (n_in != 13 || out_size != M * DM || ws_size < WS_END) { fprintf(stderr, "kernel_launch: unexpected shapes: n_in %d out %d ws %zu (need %zu)\n", n_in, out_size, ws_size, (size_t)WS_END); grid = -1; return; }
        int dev = 0, cus = 0, per_cu = 0;
        hipGetDevice(&dev); hipDeviceGetAttribute(&cus, hipDeviceAttributeMultiprocessorCount, dev);
        if (hipFuncSetAttribute((const void*)mk_fwd, hipFuncAttributeMaxDynamicSharedMemorySize, LDS_BYTES) != hipSuccess) { fprintf(stderr, "kernel_launch: hipFuncSetAttribute failed\n"); grid = -1; return; }
        hipOccupancyMaxActiveBlocksPerMultiprocessor(&per_cu, (const void*)mk_fwd, NTHR, LDS_BYTES);
        if (per_cu < 1) { fprintf(stderr, "kernel_launch: occupancy query says %d blocks per CU\n", per_cu); per_cu = 1; }
        (void)hipGetLastError();
        grid = cus * 1;
    }
    if (grid < 0) return;
    if (MK_N_LAUNCHES == 1) (void)hipMemsetAsync((char*)d_ws + WS_BAR, 0, 256, stream);
    Args a{};
    for (int i = 0; i < 13; ++i) a.in[i] = (const float*)d_in[i];
    a.out = (float*)d_out; a.ws = (unsigned char*)d_ws;
    constexpr int NPH = 8;
    for (int li = 0; li < MK_N_LAUNCHES; ++li) {
        a.ph_lo = (MK_N_LAUNCHES == 1) ? 0 : li; a.ph_hi = (MK_N_LAUNCHES == 1) ? NPH : li + 1;
        void* args[] = {&a};
        hipError_t e = hipLaunchCooperativeKernel((const void*)mk_fwd, dim3(grid), dim3(NTHR), args, LDS_BYTES, stream);
        if (e != hipSuccess) { fprintf(stderr, "kernel_launch: cooperative launch failed: %s (grid %d)\n", hipGetErrorString(e), grid); break; }
    }
}
```

```cpp
#include <hip/hip_runtime.h>
#include <hip/hip_cooperative_groups.h>
#include <cstdio>
#include <cstdint>
namespace cg = cooperative_groups;
__device__ __forceinline__ int mk_lane_id() { int l; asm volatile("v_mbcnt_lo_u32_b32 %0, -1, 0\n\tv_mbcnt_hi_u32_b32 %0, -1, %0" : "=v"(l)); return l; }
namespace pg8 {
#define PG8_LAS __attribute__((address_space(3)))
typedef unsigned short bf16_t;
typedef short bf16x8 __attribute__((ext_vector_type(8)));
typedef float f32x4 __attribute__((ext_vector_type(4)));
typedef unsigned u32x4 __attribute__((ext_vector_type(4)));
constexpr int BM = 256, BK = 64, HALF = 128, HTB = HALF * BK * 2  , STAGE_BYTES = 8 * HTB, NXCD = 8, WGM = 8;

__host__ __device__ __forceinline__ int lds_byte(int r, int c) { const int st = (r >> 4) * 2 + (c >> 5), rr = r & 15, cc = c & 31, ob = rr * 64 + cc * 2; return st * 1024 + (ob ^ (((ob >> 9) & 1) << 5)); }
__host__ __device__ __forceinline__ void stage_rc(int b, int& R, int& C) { const int st = b / 1024, sb = b % 1024, swz = sb ^ (((sb >> 9) & 1) << 5); R = (st >> 1) * 16 + swz / 64; C = (st & 1) * 32 + (swz % 64) / 2; }
__host__ __device__ __forceinline__ int perm32(int rho) { const int n = rho >> 4, i = rho & 15; return 8 * (i >> 2) + 4 * n + (i & 3); }

struct Unit { int pm, pn; };
struct Gemm { const bf16_t* A; const bf16_t* Bt; int M, N, K, lda, ldb; };

struct StaticOrder {
    int nM, nN, nwg, G, c;
    __host__ __device__ void init(int M, int N, int G_, int c_) { nM = M / BM; nN = N / BM; nwg = nM * nN; G = G_; c = c_; }
    __host__ __device__ bool next(int i, Unit& u) const {
        const long L = (long)i * G + c; if (L >= nwg) return false;
        int wgid = (int)L; { const int q = nwg / NXCD, r = nwg % NXCD, xcd = wgid % NXCD, off = wgid / NXCD; wgid = (xcd < r ? xcd * (q + 1) : r * (q + 1) + (xcd - r) * q) + off; }
        const int nig = WGM * nN, gid = wgid / nig, fm = gid * WGM, gsz = (nM - fm) < WGM ? (nM - fm) : WGM;
        u.pm = fm + ((wgid % nig) % gsz); u.pn = (wgid % nig) / gsz; return true;
    }
    __device__ __forceinline__ void a_ready(const Unit&) const {}
    __device__ __forceinline__ void done(const Unit&) const {}
};

typedef float f32x2_cv __attribute__((ext_vector_type(2))); typedef __bf16 bf16x2_cv __attribute__((ext_vector_type(2)));
__device__ __forceinline__ unsigned cvt_pk_bf16(float lo, float hi) { f32x2_cv v = {lo, hi}; bf16x2_cv b = __builtin_convertvector(v, bf16x2_cv); return __builtin_bit_cast(unsigned, b); }
typedef float f32x2 __attribute__((ext_vector_type(2)));
template <class Epi, class Sched, bool ALIGN_EPI = false, bool SP2 = false>
__device__ __forceinline__ void gemm_phase(PG8_LAS unsigned char* lds, const Gemm g, const Sched& S, const Epi& E, const int wave_s) {
    int tid = wave_s * 64 + mk_lane_id(); asm volatile("" : "+v"(tid));
    const int wid = __builtin_amdgcn_readfirstlane(tid >> 6), lane = tid & 63, wr = wid >> 2, wc = wid & 3, fr = lane & 15, fq = lane >> 4;
    const int K = g.K, nt = K / BK;
    unsigned voffA[2], voffB[2];
#pragma unroll
    for (int i = 0; i < 2; ++i) { int R, C; stage_rc(tid * 16 + i * 8192, R, C); const int Rb = Epi::PERM ? ((R & ~31) + perm32(R & 31)) : R;
        voffA[i] = (unsigned)(R * g.lda + C) * 2u; voffB[i] = (unsigned)(Rb * g.ldb + C) * 2u; }
    const size_t kstep = (size_t)(BK * 2);
    const size_t hsA = (size_t)HALF * g.lda * 2, hsB = (size_t)HALF * g.ldb * 2;
    const size_t tsA = 2 * hsA, tsB = 2 * hsB;
    const unsigned ldsw = (unsigned)wid * 1024u;
    const int aoff = lds_byte(wr * 64 + fr, fq * 8), boff = lds_byte(wc * 32 + fr, fq * 8);
#define PG8_SA(b, h) (((b) * 2 + (h)) * HTB)
#define PG8_SB(b, h) ((4 + (b) * 2 + (h)) * HTB)
#define PG8_STAGE(bufoff, gbase, voff) do { _Pragma("unroll") for (int _i = 0; _i < 2; ++_i) \
        __builtin_amdgcn_global_load_lds((const unsigned*)((const char*)(gbase) + (voff)[_i]), (PG8_LAS unsigned*)(lds + (bufoff) + ldsw + _i * 8192), 16, 0, 0); } while (0)
#define PG8_LDA(dst, b, h) do { _Pragma("unroll") for (int m = 0; m < 4; ++m) _Pragma("unroll") for (int k = 0; k < 2; ++k) dst[m][k] = *(const PG8_LAS bf16x8*)(lds + PG8_SA(b, h) + aoff + m * 2048 + k * 1024); } while (0)
#define PG8_LDB(dst, b, h) do { _Pragma("unroll") for (int n = 0; n < 2; ++n) _Pragma("unroll") for (int k = 0; k < 2; ++k) dst[n][k] = *(const PG8_LAS bf16x8*)(lds + PG8_SB(b, h) + boff + n * 2048 + k * 1024); } while (0)
#define PG8_MMA(ai, bj, At, Bt) do { __builtin_amdgcn_s_setprio(1); _Pragma("unroll") for (int m = 0; m < 4; ++m) _Pragma("unroll") for (int n = 0; n < 2; ++n) _Pragma("unroll") for (int k = 0; k < 2; ++k) \
        acc[ai][bj][m][n] = __builtin_amdgcn_mfma_f32_16x16x32_bf16(Bt[n][k], At[m][k], acc[ai][bj][m][n], 0, 0, 0); __builtin_amdgcn_s_setprio(0); } while (0)
#define PG8_WAIT_V(n) asm volatile("s_waitcnt vmcnt(" #n ")" ::: "memory")
#define PG8_WAIT_L(n) asm volatile("s_waitcnt lgkmcnt(" #n ")" ::: "memory")
#define PG8_BAR __builtin_amdgcn_s_barrier()
#define PG8_SCHED __builtin_amdgcn_sched_barrier(0)
    Unit cur, nxt; int ui = 0;
    if (!S.next(0, cur)) return;
    f32x4 acc[2][2][4][2];
#pragma unroll
    for (int a = 0; a < 2; ++a)
#pragma unroll
        for (int b = 0; b < 2; ++b)
#pragma unroll
            for (int m = 0; m < 4; ++m)
#pragma unroll
                for (int n = 0; n < 2; ++n) acc[a][b][m][n] = (f32x4){0.f, 0.f, 0.f, 0.f};
    bf16x8 At[4][2], B0[2][2], B1[2][2];
    const char* cA = (const char*)g.A + (size_t)cur.pm * tsA; const char* cB = (const char*)g.Bt + (size_t)cur.pn * tsB;
    S.a_ready(cur);
    if constexpr (SP2) {
        PG8_STAGE(PG8_SB(0, 0), cB, voffB); PG8_STAGE(PG8_SB(0, 1), cB + hsB, voffB); PG8_STAGE(PG8_SA(0, 0), cA, voffA); PG8_STAGE(PG8_SA(0, 1), cA + hsA, voffA);
        if (wr == 1) PG8_BAR;
        PG8_WAIT_V(2); PG8_BAR;
        PG8_STAGE(PG8_SB(1, 0), cB + kstep, voffB); PG8_STAGE(PG8_SA(1, 0), cA + kstep, voffA); PG8_STAGE(PG8_SB(1, 1), cB + hsB + kstep, voffB);
        PG8_WAIT_V(6); PG8_BAR;
    } else {
        PG8_STAGE(PG8_SB(0, 0), cB, voffB); PG8_STAGE(PG8_SA(0, 0), cA, voffA); PG8_STAGE(PG8_SB(0, 1), cB + hsB, voffB); PG8_STAGE(PG8_SA(0, 1), cA + hsA, voffA);
        if (wr == 1) PG8_BAR;
        PG8_WAIT_V(4); PG8_BAR;
        PG8_STAGE(PG8_SB(1, 0), cB + kstep, voffB); PG8_STAGE(PG8_SA(1, 0), cA + kstep, voffA); PG8_STAGE(PG8_SB(1, 1), cB + hsB + kstep, voffB);
        PG8_WAIT_V(6); PG8_BAR;
    }
    for (;;) {
        const bool has_next = S.next(ui + 1, nxt);
        const char* nA = has_next ? (const char*)g.A + (size_t)nxt.pm * tsA : cA; const char* nB = has_next ? (const char*)g.Bt + (size_t)nxt.pn * tsB : cB;
        for (int t = 0; t < nt; t += 2) {
            const bool last = (t == nt - 2);
            const char* a1 = cA + (size_t)(t + 1) * kstep;
            const char* a2 = last ? nA : cA + (size_t)(t + 2) * kstep; const char* b2 = last ? nB : cB + (size_t)(t + 2) * kstep;
            const char* a3 = a2 + kstep; const char* b3 = b2 + kstep;
            if (last && has_next) S.a_ready(nxt);
            if constexpr (SP2) {
            PG8_LDB(B0, 0, 0); PG8_LDB(B1, 0, 1); PG8_SCHED; PG8_LDA(At, 0, 0); PG8_STAGE(PG8_SA(1, 1), a1 + hsA, voffA);
            PG8_WAIT_V(8); PG8_WAIT_L(0); PG8_BAR; PG8_MMA(0, 0, At, B0); PG8_MMA(0, 1, At, B1); PG8_BAR; PG8_SCHED;
            PG8_LDA(At, 0, 1); PG8_STAGE(PG8_SB(0, 0), b2, voffB); PG8_STAGE(PG8_SB(0, 1), b2 + hsB, voffB); PG8_STAGE(PG8_SA(0, 0), a2, voffA);
            PG8_WAIT_V(8); PG8_WAIT_L(0); PG8_BAR; PG8_MMA(1, 0, At, B0); PG8_MMA(1, 1, At, B1); PG8_BAR; PG8_SCHED;
            PG8_LDB(B0, 1, 0); PG8_LDB(B1, 1, 1); PG8_SCHED; PG8_LDA(At, 1, 0); PG8_STAGE(PG8_SA(0, 1), a2 + hsA, voffA);
            PG8_WAIT_V(8); PG8_WAIT_L(0); PG8_BAR; PG8_MMA(0, 0, At, B0); PG8_MMA(0, 1, At, B1); PG8_BAR; PG8_SCHED;
            PG8_LDA(At, 1, 1); PG8_STAGE(PG8_SB(1, 0), b3, voffB); PG8_STAGE(PG8_SB(1, 1), b3 + hsB, voffB); PG8_STAGE(PG8_SA(1, 0), a3, voffA);
            PG8_WAIT_V(8); PG8_WAIT_L(0); PG8_BAR; PG8_MMA(1, 0, At, B0); PG8_MMA(1, 1, At, B1); PG8_BAR; PG8_SCHED;
            } else {
            PG8_LDB(B0, 0, 0); PG8_SCHED; PG8_LDA(At, 0, 0); PG8_STAGE(PG8_SA(1, 1), a1 + hsA, voffA);
            PG8_WAIT_L(8); PG8_BAR; PG8_WAIT_L(0); PG8_MMA(0, 0, At, B0); PG8_BAR; PG8_SCHED;
            PG8_LDB(B1, 0, 1); PG8_STAGE(PG8_SB(0, 0), b2, voffB);
            PG8_BAR; PG8_WAIT_L(0); PG8_MMA(0, 1, At, B1); PG8_BAR;
            PG8_LDA(At, 0, 1); PG8_STAGE(PG8_SA(0, 0), a2, voffA);
            PG8_BAR; PG8_WAIT_L(0); PG8_MMA(1, 0, At, B0); PG8_BAR; PG8_SCHED;
            PG8_STAGE(PG8_SB(0, 1), b2 + hsB, voffB);
            PG8_WAIT_V(6); PG8_BAR; PG8_MMA(1, 1, At, B1); PG8_BAR;
            PG8_LDB(B0, 1, 0); PG8_SCHED; PG8_LDA(At, 1, 0); PG8_STAGE(PG8_SA(0, 1), a2 + hsA, voffA);
            PG8_WAIT_L(8); PG8_BAR; PG8_WAIT_L(0); PG8_MMA(0, 0, At, B0); PG8_BAR; PG8_SCHED;
            PG8_LDB(B1, 1, 1); PG8_STAGE(PG8_SB(1, 0), b3, voffB);
            PG8_BAR; PG8_WAIT_L(0); PG8_MMA(0, 1, At, B1); PG8_BAR;
            PG8_LDA(At, 1, 1); PG8_STAGE(PG8_SA(1, 0), a3, voffA);
            PG8_BAR; PG8_WAIT_L(0); PG8_MMA(1, 0, At, B0); PG8_BAR; PG8_SCHED;
            PG8_STAGE(PG8_SB(1, 1), b3 + hsB, voffB);
            PG8_WAIT_V(6); PG8_BAR; PG8_MMA(1, 1, At, B1); PG8_BAR;
            }
        }
        if constexpr (ALIGN_EPI) { if (wr == 0) PG8_BAR; }
        if constexpr (!Epi::AFTER_DRAIN) { E(acc, cur, wr, wc, fr, fq); S.done(cur); }
        if (!has_next) break;
#pragma unroll
        for (int a = 0; a < 2; ++a)
#pragma unroll
            for (int b = 0; b < 2; ++b)
#pragma unroll
                for (int m = 0; m < 4; ++m)
#pragma unroll
                    for (int n = 0; n < 2; ++n) acc[a][b][m][n] = (f32x4){0.f, 0.f, 0.f, 0.f};
        cur = nxt; cA = nA; cB = nB; ++ui;
        if constexpr (ALIGN_EPI) { if (wr == 1) PG8_BAR; }
    }
    PG8_WAIT_V(0);
    if constexpr (!ALIGN_EPI) { if (wr == 0) PG8_BAR; }
    PG8_BAR;
    if constexpr (Epi::AFTER_DRAIN) { E.fused(acc, cur, wr, wc, fr, fq, lds, wid, lane); S.done(cur); }
#undef PG8_SA
#undef PG8_SB
#undef PG8_STAGE
#undef PG8_LDA
#undef PG8_LDB
#undef PG8_MMA
#undef PG8_WAIT_V
#undef PG8_WAIT_L
#undef PG8_BAR
#undef PG8_SCHED
}
}

using pg8::bf16_t; using pg8::bf16x8; using pg8::f32x4; using pg8::u32x4; using pg8::Unit; using pg8::cvt_pk_bf16;
#define LAS __attribute__((address_space(3)))
typedef float f32x16 __attribute__((ext_vector_type(16)));
typedef unsigned u32x2 __attribute__((ext_vector_type(2)));
constexpr int M = 32768, SEQ = 4096, DM = 1024;
constexpr int NZ = 4352;
constexpr int OKV = 384, OKR = 640, OGA = 672, OU = 1184, OGP = 1696, OGMA = 2208, OGMP = 3232;
constexpr float EPS = 1e-6f;
constexpr float LOG2E = 1.4426950408889634f;
constexpr float C2 = 0.10206207261596577f * 1.4426950408889634f;
constexpr size_t MiB = 1u << 20;
constexpr size_t WS_SSQ = 0;
constexpr size_t WS_BAR = 384 * 1024;
constexpr size_t WS_CS = 512 * 1024;
constexpr size_t WS_WIN = 1 * MiB, WS_WQ = 10 * MiB, WS_WK = 11 * MiB, WS_WV = 11 * MiB + 512 * 1024, WS_WBD = 12 * MiB, WS_WA = 13 * MiB, WS_WP = 14 * MiB, WS_WO = 15 * MiB;
constexpr size_t WS_R64 = 18 * MiB;
constexpr size_t WS_Z = 82 * MiB;
constexpr size_t WS_YA = 354 * MiB, WS_YP = 386 * MiB, WS_MG = 418 * MiB, WS_END = 482 * MiB;
constexpr size_t DO_Q = 0, DO_KN = 48 * MiB, DO_VT = 80 * MiB, DO_KR = 112 * MiB;

__device__ __forceinline__ float ex2(float x) { return __builtin_amdgcn_exp2f(x); }
__device__ __forceinline__ float rcpf_(float x) { return __builtin_amdgcn_rcpf(x); }
__device__ __forceinline__ float sigmoidf_(float x) { return rcpf_(1.f + ex2(-x * LOG2E)); }
__device__ __forceinline__ float siluf_(float x) { return x * sigmoidf_(x); }
__device__ __forceinline__ void unpack8(u32x4 w, float (&f)[8]) {
    f[0] = __uint_as_float(w.x << 16); f[1] = __uint_as_float(w.x & 0xffff0000u); f[2] = __uint_as_float(w.y << 16); f[3] = __uint_as_float(w.y & 0xffff0000u);
    f[4] = __uint_as_float(w.z << 16); f[5] = __uint_as_float(w.z & 0xffff0000u); f[6] = __uint_as_float(w.w << 16); f[7] = __uint_as_float(w.w & 0xffff0000u);
}
__device__ __forceinline__ u32x4 pack8(const float (&f)[8]) { u32x4 w; w.x = cvt_pk_bf16(f[0], f[1]); w.y = cvt_pk_bf16(f[2], f[3]); w.z = cvt_pk_bf16(f[4], f[5]); w.w = cvt_pk_bf16(f[6], f[7]); return w; }

#define EPI_LOOP_BEGIN(ldc_) \
    int fr_ = fr, fq_ = fq; asm volatile("" : "+v"(fr_), "+v"(fq_));     \
    const int row0 = u.pm * pg8::BM + wr * 64 + fr_; const int col0 = u.pn * pg8::BM + wc * 32 + 8 * fq_; \
    _Pragma("unroll") for (int ai = 0; ai < 2; ++ai) _Pragma("unroll") for (int m = 0; m < 4; ++m) { const int row = row0 + ai * pg8::HALF + m * 16; \
    _Pragma("unroll") for (int bj = 0; bj < 2; ++bj) { const int col = col0 + bj * pg8::HALF; \
        float v[8] = {acc[ai][bj][m][0][0], acc[ai][bj][m][0][1], acc[ai][bj][m][0][2], acc[ai][bj][m][0][3], acc[ai][bj][m][1][0], acc[ai][bj][m][1][1], acc[ai][bj][m][1][2], acc[ai][bj][m][1][3]};
#define EPI_LOOP_END } asm volatile("" ::: "memory"); }

struct EpiZ { static constexpr bool PERM = true, AFTER_DRAIN = false;
    bf16_t* O;
    __device__ __forceinline__ void operator()(const f32x4 (&acc)[2][2][4][2], const Unit& u, int wr, int wc, int fr, int fq) const {
        EPI_LOOP_BEGIN(NZ)
            *(u32x4*)(O + (size_t)row * NZ + col) = pack8(v);
        EPI_LOOP_END
    }
};
struct EpiRowScale { static constexpr bool PERM = true, AFTER_DRAIN = false;
    bf16_t* O; const float* rstd; int ldc; float mul;
    __device__ __forceinline__ void operator()(const f32x4 (&acc)[2][2][4][2], const Unit& u, int wr, int wc, int fr, int fq) const {
        EPI_LOOP_BEGIN(ldc)
            const float sc = rstd[row] * mul;
#pragma unroll
            for (int j = 0; j < 8; ++j) v[j] *= sc;
            *(u32x4*)(O + (size_t)row * ldc + col) = pack8(v);
        EPI_LOOP_END
    }
};
struct EpiVT { static constexpr bool PERM = true, AFTER_DRAIN = false;
    bf16_t* O; const float* rstd;
    __device__ __forceinline__ void operator()(const f32x4 (&acc)[2][2][4][2], const Unit& u, int wr, int wc, int fr, int fq) const {
        EPI_LOOP_BEGIN(M)
            const f32x4 q0 = *(const f32x4*)(rstd + col), q1 = *(const f32x4*)(rstd + col + 4);
            const float qq[8] = {q0[0], q0[1], q0[2], q0[3], q1[0], q1[1], q1[2], q1[3]};
#pragma unroll
            for (int j = 0; j < 8; ++j) v[j] *= qq[j];
            *(u32x4*)(O + (size_t)row * M + col) = pack8(v);
        EPI_LOOP_END
    }
};
struct EpiPool { static constexpr bool PERM = true, AFTER_DRAIN = false;
    bf16_t* O; const bf16_t* Z;
    __device__ __forceinline__ void operator()(const f32x4 (&acc)[2][2][4][2], const Unit& u, int wr, int wc, int fr, int fq) const {
        EPI_LOOP_BEGIN(512)
            float g[8]; unpack8(*(const u32x4*)(Z + (size_t)row * NZ + OGP + col), g);
#pragma unroll
            for (int j = 0; j < 8; ++j) v[j] *= siluf_(g[j]);
            *(u32x4*)(O + (size_t)row * 512 + col) = pack8(v);
        EPI_LOOP_END
    }
};
template <bool ADD> struct EpiMerge { static constexpr bool PERM = true, AFTER_DRAIN = false;
    bf16_t* O; const bf16_t* Z; const bf16_t* T; int og;
    __device__ __forceinline__ void operator()(const f32x4 (&acc)[2][2][4][2], const Unit& u, int wr, int wc, int fr, int fq) const {
        EPI_LOOP_BEGIN(1024)
            float g[8]; unpack8(*(const u32x4*)(Z + (size_t)row * NZ + og + col), g);
            float tt[8];
            if (ADD) unpack8(*(const u32x4*)(T + (size_t)row * 1024 + col), tt);
#pragma unroll
            for (int j = 0; j < 8; ++j) { v[j] *= sigmoidf_(g[j]); if (ADD) v[j] += tt[j]; }
            *(u32x4*)(O + (size_t)row * 1024 + col) = pack8(v);
        EPI_LOOP_END
    }
};
struct EpiOut { static constexpr bool PERM = true, AFTER_DRAIN = false;
    const float* X; float* O;
    __device__ __forceinline__ void operator()(const f32x4 (&acc)[2][2][4][2], const Unit& u, int wr, int wc, int fr, int fq) const {
        EPI_LOOP_BEGIN(1024)
            const f32x4 x0 = *(const f32x4*)(X + (size_t)row * 1024 + col), x1 = *(const f32x4*)(X + (size_t)row * 1024 + col + 4);
            f32x4 h0 = {v[0] + x0[0], v[1] + x0[1], v[2] + x0[2], v[3] + x0[3]}, h1 = {v[4] + x1[0], v[5] + x1[1], v[6] + x1[2], v[7] + x1[3]};
            *(f32x4*)(O + (size_t)row * 1024 + col) = h0; *(f32x4*)(O + (size_t)row * 1024 + col + 4) = h1;
        EPI_LOOP_END
    }
};

namespace att {
constexpr int KPB = 208, VPB = 136;
constexpr int KBYTES = 64 * KPB, VBYTES = 64 * VPB, BUFB = KBYTES + VBYTES;
__device__ __forceinline__ bf16x8 pk8(const f32x16& p, int b) {
    u32x4 w; w.x = cvt_pk_bf16(p[b], p[b + 1]); w.y = cvt_pk_bf16(p[b + 2], p[b + 3]); w.z = cvt_pk_bf16(p[b + 4], p[b + 5]); w.w = cvt_pk_bf16(p[b + 6], p[b + 7]);
    return __builtin_bit_cast(bf16x8, w);
}
__device__ __forceinline__ void attn_unit(int b, int h, int qb, const bf16_t* __restrict__ Q, const bf16_t* __restrict__ KN, const bf16_t* __restrict__ KR, const bf16_t* __restrict__ VT,
                                          const bf16_t* __restrict__ Z, const float* __restrict__ cs, bf16_t* __restrict__ YA, LAS unsigned char* lds, const int wave_s) {
    int tid = wave_s * 64 + mk_lane_id(); asm volatile("" : "+v"(tid));
    const int lane = tid & 63, r32 = lane & 31, hi = lane >> 5;
    const int wid = __builtin_amdgcn_readfirstlane(tid >> 6);
    const size_t rowbase = (size_t)b * SEQ;
    const int q0 = qb * 256, myq = q0 + wid * 32 + r32, cw = (q0 + wid * 32) >> 6, NT = (q0 + 256) >> 6;
    bf16x8 qr[6];
    { const bf16_t* qp = Q + (rowbase + myq) * 768 + h * 96 + 8 * hi;
#pragma unroll
      for (int s = 0; s < 6; ++s) qr[s] = *(const bf16x8*)(qp + 16 * s);
      float x1[8], x2[8], r1[8], r2[8]; unpack8(__builtin_bit_cast(u32x4, qr[4]), x1); unpack8(__builtin_bit_cast(u32x4, qr[5]), x2);
      const float* c = cs + (size_t)myq * 32 + 8 * hi;
#pragma unroll
      for (int e = 0; e < 8; ++e) { const float cc = c[e], sn = c[16 + e]; r1[e] = x1[e] * cc - x2[e] * sn; r2[e] = x1[e] * sn + x2[e] * cc; }
      qr[4] = __builtin_bit_cast(bf16x8, pack8(r1)); qr[5] = __builtin_bit_cast(bf16x8, pack8(r2)); }
    const int kr_ = tid >> 3, kc_ = tid & 7, rr_ = (tid & 255) >> 2, rc_ = tid & 3;
    const bf16_t* kn_src = KN + (rowbase + kr_) * 512 + h * 64 + kc_ * 8;
    const bf16_t* kr_src = KR + (rowbase + rr_) * 32 + rc_ * 8;
    const bf16_t* vt_src = VT + (size_t)(h * 64 + kr_) * M + rowbase + kc_ * 8;
    const unsigned kn_dst = kr_ * KPB + kc_ * 16, kr_dst = rr_ * KPB + 128 + rc_ * 16, vt_dst = KBYTES + kr_ * VPB + kc_ * 16;
    const bool has_r = tid < 256;
    u32x4 sk, sr = {0u, 0u, 0u, 0u}, sv;
    sk = *(const u32x4*)kn_src; if (has_r) sr = *(const u32x4*)kr_src; sv = *(const u32x4*)vt_src;
    *(LAS u32x4*)(lds + kn_dst) = sk; if (has_r) *(LAS u32x4*)(lds + kr_dst) = sr;
    *(LAS u32x2*)(lds + vt_dst) = (u32x2){sv.x, sv.y}; *(LAS u32x2*)(lds + vt_dst + 8) = (u32x2){sv.z, sv.w};
    __syncthreads();
    float mref = -INFINITY, lsum = 0.f;
    f32x16 o0, o1;
#pragma unroll
    for (int r = 0; r < 16; ++r) { o0[r] = 0.f; o1[r] = 0.f; }
    for (int t = 0; t < NT; ++t) {
        const bool more = (t + 1 < NT);
        if (more) { sk = *(const u32x4*)(kn_src + (size_t)(t + 1) * 64 * 512); if (has_r) sr = *(const u32x4*)(kr_src + (size_t)(t + 1) * 64 * 32); sv = *(const u32x4*)(vt_src + (size_t)(t + 1) * 64); }
        if (t <= cw) {
            LAS const unsigned char* buf = lds + (t & 1) * BUFB;
            LAS const unsigned char* kb = buf + r32 * KPB + hi * 16;
            f32x16 p0, p1;
#pragma unroll
            for (int r = 0; r < 16; ++r) { p0[r] = 0.f; p1[r] = 0.f; }
#pragma unroll
            for (int s = 0; s < 6; ++s) {
                const bf16x8 a0 = *(LAS const bf16x8*)(kb + s * 32), a1 = *(LAS const bf16x8*)(kb + 32 * KPB + s * 32);
                p0 = __builtin_amdgcn_mfma_f32_32x32x16_bf16(a0, qr[s], p0, 0, 0, 0);
                p1 = __builtin_amdgcn_mfma_f32_32x32x16_bf16(a1, qr[s], p1, 0, 0, 0);
            }
            float rm = fmaxf(p0[0], p1[0]);
#pragma unroll
            for (int r = 1; r < 16; ++r) rm = fmaxf(rm, fmaxf(p0[r], p1[r]));
            rm = fmaxf(rm, __shfl_xor(rm, 32));
            if (__any(rm > mref + 8.f)) {
                const float mn = fmaxf(mref, rm), al = ex2(mref - mn);
                lsum *= al;
#pragma unroll
                for (int r = 0; r < 16; ++r) { o0[r] *= al; o1[r] *= al; }
                mref = mn;
            }
            float ls = 0.f;
#pragma unroll
            for (int r = 0; r < 16; ++r) { p0[r] = ex2(p0[r] - mref); p1[r] = ex2(p1[r] - mref); ls += p0[r] + p1[r]; }
            lsum += ls;
            bf16x8 pf[4]; pf[0] = pk8(p0, 0); pf[1] = pk8(p0, 8); pf[2] = pk8(p1, 0); pf[3] = pk8(p1, 8);
            LAS const unsigned char* vb = buf + KBYTES + r32 * VPB + hi * 8;
#pragma unroll
            for (int i = 0; i < 4; ++i) {
                const u32x2 a = *(LAS const u32x2*)(vb + i * 32), c = *(LAS const u32x2*)(vb + i * 32 + 16);
                const u32x2 a2 = *(LAS const u32x2*)(vb + 32 * VPB + i * 32), c2 = *(LAS const u32x2*)(vb + 32 * VPB + i * 32 + 16);
                o0 = __builtin_amdgcn_mfma_f32_32x32x16_bf16(__builtin_bit_cast(bf16x8, (u32x4){a.x, a.y, c.x, c.y}), pf[i], o0, 0, 0, 0);
                o1 = __builtin_amdgcn_mfma_f32_32x32x16_bf16(__builtin_bit_cast(bf16x8, (u32x4){a2.x, a2.y, c2.x, c2.y}), pf[i], o1, 0, 0, 0);
            }
        }
        if (more) { LAS unsigned char* nb = lds + ((t + 1) & 1) * BUFB;
            *(LAS u32x4*)(nb + kn_dst) = sk; if (has_r) *(LAS u32x4*)(nb + kr_dst) = sr;
            *(LAS u32x2*)(nb + vt_dst) = (u32x2){sv.x, sv.y}; *(LAS u32x2*)(nb + vt_dst + 8) = (u32x2){sv.z, sv.w}; }
        __syncthreads();
    }
    const float inv = rcpf_(lsum + __shfl_xor(lsum, 32));
    bf16_t* yp = YA + (rowbase + myq) * 512 + h * 64 + 4 * hi;
    const bf16_t* gp = Z + (rowbase + myq) * NZ + OGA + h * 64 + 4 * hi;
#pragma unroll
    for (int db = 0; db < 2; ++db)
#pragma unroll
        for (int g4 = 0; g4 < 4; ++g4) {
            const u32x2 gw = *(const u32x2*)(gp + 32 * db + 8 * g4);
            const float g0 = __uint_as_float(gw.x << 16), g1 = __uint_as_float(gw.x & 0xffff0000u), g2 = __uint_as_float(gw.y << 16), g3 = __uint_as_float(gw.y & 0xffff0000u);
            const f32x16& o = db ? o1 : o0;
            u32x2 w; w.x = cvt_pk_bf16(o[4 * g4] * inv * siluf_(g0), o[4 * g4 + 1] * inv * siluf_(g1)); w.y = cvt_pk_bf16(o[4 * g4 + 2] * inv * siluf_(g2), o[4 * g4 + 3] * inv * siluf_(g3));
            *(u32x2*)(yp + 32 * db + 8 * g4) = w;
        }
}
}

typedef unsigned v4u __attribute__((ext_vector_type(4)));
__device__ __forceinline__ float wave_sum(float v) {
#pragma unroll
    for (int o = 1; o < 64; o <<= 1) v += __shfl_xor(v, o);
    return v;
}
__device__ __forceinline__ void transpose_item(const float* __restrict__ W, int N, bf16_t* dst, int ldk, const float* kscale, LAS float* scr, int k0, int n0, int lane) {
#pragma unroll 8
    for (int i = 0; i < 32; ++i) { const int kk = 2 * i + (lane >> 5); const float s = kscale ? kscale[k0 + kk] : 1.f; scr[kk * 33 + (lane & 31)] = W[(size_t)(k0 + kk) * N + n0 + (lane & 31)] * s; }
    asm volatile("s_waitcnt lgkmcnt(0)" ::: "memory");
    const int c = lane & 7;
#pragma unroll
    for (int j = 0; j < 4; ++j) { const int n = (lane >> 3) + 8 * j; const LAS float* s = scr + (8 * c) * 33 + n;
        v4u o; o.x = cvt_pk_bf16(s[0 * 33], s[1 * 33]); o.y = cvt_pk_bf16(s[2 * 33], s[3 * 33]); o.z = cvt_pk_bf16(s[4 * 33], s[5 * 33]); o.w = cvt_pk_bf16(s[6 * 33], s[7 * 33]);
        *(v4u*)(dst + (size_t)n * ldk + k0 + 8 * c) = o; }
    asm volatile("s_waitcnt lgkmcnt(0)" ::: "memory");
}

#define XB_TMO      128
#define XB_XCNT(j)  (256  + 64 * (j))
#define XB_XSUB(j)  (1280 + 64 * (j))
#define XB_XGEN(j)  (2304 + 64 * (j))
#define XB_TOP      3328
#define XB_TOPGEN   3392
#define XCD_BAR_WORDS 3456
#define XB_SPIN_CAP (1u << 18)

__device__ __forceinline__ unsigned xb_ld(unsigned* p)              { return __hip_atomic_load(p, __ATOMIC_RELAXED, __HIP_MEMORY_SCOPE_AGENT); }
__device__ __forceinline__ unsigned xb_add(unsigned* p, unsigned v) { return __hip_atomic_fetch_add(p, v, __ATOMIC_RELAXED, __HIP_MEMORY_SCOPE_AGENT); }
__device__ __forceinline__ unsigned xb_xcc_id() { return (unsigned)__builtin_amdgcn_s_getreg((3 << 11) | 20) & 0xFu; }
#define XB_SPIN(cond, bar) do { unsigned _sp = 0; while (cond) { __builtin_amdgcn_s_sleep(1); \
    if ((++_sp & 255u) == 0u) { if (xb_ld(&(bar)[XB_TMO])) break; if (_sp > XB_SPIN_CAP) { atomicAdd(&(bar)[XB_TMO], 1u); break; } } } } while (0)

struct XcdBarrier {
    unsigned* bar; unsigned x;
    volatile LAS unsigned* st;
};

__device__ __forceinline__ XcdBarrier xcd_barrier_post(unsigned* bar, volatile LAS unsigned* st, bool leader) {
    XcdBarrier b; b.bar = bar; b.x = xb_xcc_id(); b.st = st;
    if (leader) (void)xb_add(&bar[XB_XCNT(b.x)], 1u);
    return b;
}
__device__ __forceinline__ void xcd_barrier_complete(unsigned* bar, unsigned x, unsigned& nloc, unsigned& nx) {
    const unsigned G = gridDim.x * gridDim.y * gridDim.z;
    unsigned sum, cnt, mine, sp = 0u;
    for (;;) {
        sum = 0u; cnt = 0u; mine = 0u;
#pragma unroll
        for (unsigned j = 0; j < 16; ++j) { const unsigned c = xb_ld(&bar[XB_XCNT(j)]); sum += c; cnt += (c > 0u) ? 1u : 0u; mine = (j == x) ? c : mine; }
        if (sum == G) break;
        __builtin_amdgcn_s_sleep(1);
        if ((++sp & 255u) == 0u) { if (xb_ld(&bar[XB_TMO])) break; if (sp > XB_SPIN_CAP) { atomicAdd(&bar[XB_TMO], 1u); break; } }
    }
    nloc = mine > 0u ? mine : 1u; nx = cnt > 0u ? cnt : 1u;
}

__device__ __forceinline__ void xcd_barrier(const XcdBarrier& b, bool leader) {
    asm volatile("s_waitcnt vmcnt(0)" ::: "memory");
    __syncthreads();
    if (leader) {
        unsigned* bar = b.bar;
        __builtin_amdgcn_s_waitcnt(0);
        unsigned nloc = b.st[0], nx = b.st[1];
        if (nloc == 0u) { xcd_barrier_complete(bar, b.x, nloc, nx); b.st[0] = nloc; b.st[1] = nx; }
        const unsigned old = xb_add(&bar[XB_XSUB(b.x)], 1u);
        const unsigned gen = old / nloc;
        if (old + 1u == (gen + 1u) * nloc) {
            __builtin_amdgcn_fence(__ATOMIC_RELEASE, "agent");
            asm volatile("s_waitcnt vmcnt(0)" ::: "memory");
            const unsigned og = xb_add(&bar[XB_TOP], 1u);
            const unsigned tg = og / nx;
            if (og + 1u == (tg + 1u) * nx) xb_add(&bar[XB_TOPGEN], 1u);
            else XB_SPIN(xb_ld(&bar[XB_TOPGEN]) == tg, bar);
            __builtin_amdgcn_fence(__ATOMIC_ACQUIRE, "agent");
            xb_add(&bar[XB_XGEN(b.x)], 1u);
            asm volatile("s_waitcnt vmcnt(0)" ::: "memory");
        } else {
            XB_SPIN(xb_ld(&bar[XB_XGEN(b.x)]) == gen, bar);
            __builtin_amdgcn_fence(__ATOMIC_ACQUIRE, "agent");
            asm volatile("s_waitcnt vmcnt(0)" ::: "memory");
        }
    }
    __syncthreads();
}

struct Args { const float* in[13]; float* out; unsigned char* ws; int ph_lo, ph_hi; };
constexpr int NWAVES = 8, NTHR = 512;
constexpr int PROBE_MASK = 0;
constexpr int LDS_BYTES = 135168;

__global__ void __launch_bounds__(NTHR, 2) mk_fwd(Args a) {
    extern __shared__ __attribute__((aligned(16))) unsigned char lds_raw[];
    LAS unsigned char* lds = (LAS unsigned char*)lds_raw;
    cg::grid_group grid = cg::this_grid();
    const int wave_s = __builtin_amdgcn_readfirstlane(threadIdx.x >> 6);
    const int G = gridDim.x, bx = blockIdx.x;
    const int vcu = (G % 8 == 0) ? (bx % 8) * (G / 8) + bx / 8 : bx;
    const int NGW = G * NWAVES, NGT = G * NTHR;
#define PHASE_IDS int tid = wave_s * 64 + mk_lane_id(); asm volatile("" : "+v"(tid)); const int lane = tid & 63, wave = __builtin_amdgcn_readfirstlane(tid >> 6), gw = vcu * NWAVES + wave, gtid = vcu * NTHR + tid; (void)lane; (void)gw; (void)gtid;
    const float* x = a.in[0]; const float* norm_in = a.in[1]; const float* w_in = a.in[2]; const float* q_norm = a.in[3]; const float* w_uq = a.in[4];
    const float* kv_norm = a.in[5]; const float* w_ukv = a.in[6]; const float* pool_w = a.in[7]; const float* pool_scale = a.in[8];
    const float* w_ba = a.in[9]; const float* w_bp = a.in[10]; const float* w_out = a.in[11]; const float* norm_final = a.in[12];
    unsigned char* ws = a.ws; unsigned char* dob = (unsigned char*)a.out;
    float* rstd_q = (float*)(ws + WS_SSQ); float* rstd_kv = rstd_q + M; float* cs = (float*)(ws + WS_CS);
    bf16_t* WinT = (bf16_t*)(ws + WS_WIN); bf16_t* WqT = (bf16_t*)(ws + WS_WQ); bf16_t* WkT = (bf16_t*)(ws + WS_WK); bf16_t* WvT = (bf16_t*)(ws + WS_WV);
    bf16_t* WbdT = (bf16_t*)(ws + WS_WBD); bf16_t* WaT = (bf16_t*)(ws + WS_WA); bf16_t* WpT = (bf16_t*)(ws + WS_WP); bf16_t* WoT = (bf16_t*)(ws + WS_WO);
    bf16_t* XN = (bf16_t*)(ws + WS_R64); bf16_t* DP = XN; bf16_t* TT = XN;
    bf16_t* Z = (bf16_t*)(ws + WS_Z); bf16_t* YA = (bf16_t*)(ws + WS_YA); bf16_t* YP = (bf16_t*)(ws + WS_YP); bf16_t* MG = (bf16_t*)(ws + WS_MG);
    bf16_t* Qb = (bf16_t*)(dob + DO_Q); bf16_t* KN = (bf16_t*)(dob + DO_KN); bf16_t* VT = (bf16_t*)(dob + DO_VT); bf16_t* KR = (bf16_t*)(dob + DO_KR);
    const int lo = a.ph_lo, hi_ = a.ph_hi;
#define IN(k) (lo <= (k) && (k) < hi_)
    if (a.ph_lo < 0) grid.sync();
    { PHASE_IDS for (int u_ = tid; u_ < 64; u_ += NTHR) ((LAS unsigned*)(lds + 131072))[u_] = 0u; }
    __syncthreads();
    const XcdBarrier xbar = xcd_barrier_post((unsigned*)(ws + WS_BAR), (volatile LAS unsigned*)(lds + 131072 + 32), wave_s == 0 && mk_lane_id() == 0);
#define SEAM(k) do { if (IN(k) && IN((k) + 1)) xcd_barrier(xbar, wave_s == 0 && mk_lane_id() == 0); } while (0)
    if (IN(0)) for (int rep_ = 0; rep_ < 1 + ((PROBE_MASK >> 0) & 1); ++rep_) { PHASE_IDS
        LAS float* scr = (LAS float*)(lds + wave * 16384);
        constexpr int I_IN = 16 * 133, I_Q = 6 * 24, I_KV = 4 * 32, I_A = 8 * 32, I_P = 8 * 32, I_O = 16 * 32, NITEMS = I_IN + I_Q + I_KV + I_A + I_P + I_O;
        for (int it = gw; it < NITEMS; it += NGW) {
            int r = it;
            if (r < I_IN) { const int kb = r / 133, nb = r % 133; transpose_item(w_in, 4256, WinT + (size_t)(32 * nb) * 1024, 1024, nullptr, scr, 64 * kb, 32 * nb, lane); continue; } r -= I_IN;
            if (r < I_Q) { const int kb = r / 24, nb = r % 24; transpose_item(w_uq, 768, WqT + (size_t)(32 * nb) * 384, 384, q_norm, scr, 64 * kb, 32 * nb, lane); continue; } r -= I_Q;
            if (r < I_KV) { const int kb = r / 32, nb = r % 32; const int n0 = 32 * nb, hh = n0 >> 7, j0 = n0 & 127;
                bf16_t* dst = (j0 < 64) ? WkT + (size_t)(64 * hh + j0) * 256 : WvT + (size_t)(64 * hh + j0 - 64) * 256;
                transpose_item(w_ukv, 1024, dst, 256, kv_norm, scr, 64 * kb, n0, lane); continue; } r -= I_KV;
            if (r < I_A) { const int kb = r / 32, nb = r % 32; transpose_item(w_ba, 1024, WaT + (size_t)(32 * nb) * 512, 512, nullptr, scr, 64 * kb, 32 * nb, lane); continue; } r -= I_A;
            if (r < I_P) { const int kb = r / 32, nb = r % 32; transpose_item(w_bp, 1024, WpT + (size_t)(32 * nb) * 512, 512, nullptr, scr, 64 * kb, 32 * nb, lane); continue; } r -= I_P;
            { const int kb = r / 32, nb = r % 32; transpose_item(w_out, 1024, WoT + (size_t)(32 * nb) * 1024, 1024, nullptr, scr, 64 * kb, 32 * nb, lane); }
        }
        for (int i = gtid; i < 12288; i += NGT) ((v4u*)(WinT + (size_t)4256 * 1024))[i] = (v4u){0u, 0u, 0u, 0u};
        for (int i = gtid; i < 512 * 256; i += NGT) { const int n = i >> 8, k = (i & 255) * 2; float v0 = 0.f, v1 = 0.f;
            if ((k >> 7) == (n >> 7)) { const float sc = pool_scale[n]; const float* p = pool_w + (size_t)(n >> 7) * 16384 + (size_t)(k & 127) * 128 + (n & 127); v0 = p[0] * sc; v1 = p[128] * sc; }
            ((unsigned*)WbdT)[i] = cvt_pk_bf16(v0, v1); }
        for (int i = gtid; i < SEQ * 16; i += NGT) { const int s = i >> 4, f = i & 15;
            const float inv_freq = exp2f(-(float)f * 0.83048202372184059f);
            const float ang = (float)s * inv_freq;
            const double rev = (double)ang * 0.15915494309189535; const float fr_ = (float)(rev - rint(rev));
            cs[s * 32 + f] = __builtin_amdgcn_cosf(fr_); cs[s * 32 + 16 + f] = __builtin_amdgcn_sinf(fr_); }
        for (int m = gw; m < M; m += NGW) {
            const f32x4* xr = (const f32x4*)(x + (size_t)m * DM) + lane; const f32x4* gr = (const f32x4*)norm_in + lane;
            f32x4 v[4]; float s = 0.f;
#pragma unroll
            for (int j = 0; j < 4; ++j) { v[j] = xr[64 * j]; s += (v[j][0] * v[j][0] + v[j][1] * v[j][1]) + (v[j][2] * v[j][2] + v[j][3] * v[j][3]); }
            const float rstd = rsqrtf(wave_sum(s) * (1.f / DM) + EPS);
            u32x2* o8 = (u32x2*)(XN + (size_t)m * DM) + lane;
#pragma unroll
            for (int j = 0; j < 4; ++j) { const f32x4 g = gr[64 * j]; u32x2 w; w.x = cvt_pk_bf16(v[j][0] * rstd * g[0], v[j][1] * rstd * g[1]); w.y = cvt_pk_bf16(v[j][2] * rstd * g[2], v[j][3] * rstd * g[3]); o8[64 * j] = w; }
        }
        __syncthreads();
    }
    SEAM(0);
    if (IN(1)) for (int rep_ = 0; rep_ < 1 + ((PROBE_MASK >> 1) & 1); ++rep_) {
        pg8::Gemm g{XN, WinT, M, NZ, 1024, 1024, 1024}; pg8::StaticOrder S; S.init(M, NZ, G, bx);
        EpiZ E{Z};
        pg8::gemm_phase<EpiZ, pg8::StaticOrder, true, true>(lds, g, S, E, wave_s);
    }
    SEAM(1);
    if (IN(2)) for (int rep_ = 0; rep_ < 1 + ((PROBE_MASK >> 2) & 1); ++rep_) { PHASE_IDS
        for (int m = gw; m < M; m += NGW) {
            const bf16_t* zr = Z + (size_t)m * NZ; float f[8], sq = 0.f, sk = 0.f;
            unpack8(*(const u32x4*)(zr + 8 * lane), f); float s0 = 0.f;
#pragma unroll
            for (int e = 0; e < 8; ++e) s0 += f[e] * f[e];
            if (lane < 48) sq = s0; else sk = s0;
            if (lane < 16) { unpack8(*(const u32x4*)(zr + 512 + 8 * lane), f);
#pragma unroll
                for (int e = 0; e < 8; ++e) sk += f[e] * f[e]; }
            sq = wave_sum(sq); sk = wave_sum(sk);
            if (lane == 0) { rstd_q[m] = rsqrtf(sq * (1.f / 384.f) + EPS); rstd_kv[m] = rsqrtf(sk * (1.f / 256.f) + EPS); }
        }
        for (int i = gtid; i < (M / 16) * 64; i += NGT) {
            const int ch = i & 63, rb = i >> 6, c0 = 8 * ch, w = 2 << (c0 >> 7), rg0 = 16 * rb, t0 = rg0 & (SEQ - 1);
            const bf16_t* up = Z + (size_t)rg0 * NZ + OU + c0; bf16_t* dp = DP + (size_t)rg0 * 512 + c0;
            float sum[8] = {0.f, 0.f, 0.f, 0.f, 0.f, 0.f, 0.f, 0.f};
            for (int j = 1; j < w; ++j) if (t0 - j >= 0) { float f[8]; unpack8(*(const u32x4*)(up - (ptrdiff_t)j * NZ), f);
#pragma unroll
                for (int e = 0; e < 8; ++e) sum[e] += f[e]; }
            for (int r = 0; r < 16; ++r) { const int t = t0 + r; float cur[8]; unpack8(*(const u32x4*)(up + (size_t)r * NZ), cur);
                const float ic = 1.f / (float)min(t + 1, w); float o[8];
#pragma unroll
                for (int e = 0; e < 8; ++e) { sum[e] += cur[e]; o[e] = sum[e] * ic - cur[e]; }
                *(u32x4*)(dp + (size_t)r * 512) = pack8(o);
                if (t - w + 1 >= 0) { float f[8]; unpack8(*(const u32x4*)(up + (ptrdiff_t)(r - w + 1) * NZ), f);
#pragma unroll
                    for (int e = 0; e < 8; ++e) sum[e] -= f[e]; } }
        }
        for (int i = gtid; i < M * 2; i += NGT) { const int row = i >> 1, i0 = 8 * (i & 1), s = row & (SEQ - 1);
            float x1[8], x2[8]; unpack8(*(const u32x4*)(Z + (size_t)row * NZ + OKR + i0), x1); unpack8(*(const u32x4*)(Z + (size_t)row * NZ + OKR + 16 + i0), x2);
            const float* c = cs + s * 32 + i0; float o1[8], o2[8];
#pragma unroll
            for (int e = 0; e < 8; ++e) { const float cc = c[e], sn = c[16 + e]; o1[e] = x1[e] * cc - x2[e] * sn; o2[e] = x1[e] * sn + x2[e] * cc; }
            *(u32x4*)(KR + (size_t)row * 32 + i0) = pack8(o1); *(u32x4*)(KR + (size_t)row * 32 + 16 + i0) = pack8(o2); }
    }
    SEAM(2);
    if (IN(3)) for (int rep_ = 0; rep_ < 1 + ((PROBE_MASK >> 3) & 1); ++rep_) {
        { pg8::Gemm g{Z, WqT, M, 768, 384, NZ, 384}; pg8::StaticOrder S; S.init(M, 768, G, bx); EpiRowScale E{Qb, rstd_q, 768, C2};
          pg8::gemm_phase<EpiRowScale, pg8::StaticOrder, true, true>(lds, g, S, E, wave_s); }
        { pg8::Gemm g{Z + OKV, WkT, M, 512, 256, NZ, 256}; pg8::StaticOrder S; S.init(M, 512, G, bx); EpiRowScale E{KN, rstd_kv, 512, 1.f};
          pg8::gemm_phase<EpiRowScale, pg8::StaticOrder, true, true>(lds, g, S, E, wave_s); }
        { pg8::Gemm g{WvT, Z + OKV, 512, M, 256, 256, NZ}; pg8::StaticOrder S; S.init(512, M, G, bx); EpiVT E{VT, rstd_kv};
          pg8::gemm_phase<EpiVT, pg8::StaticOrder, true, true>(lds, g, S, E, wave_s); }
        { pg8::Gemm g{DP, WbdT, M, 512, 512, 512, 512}; pg8::StaticOrder S; S.init(M, 512, G, bx); EpiPool E{YP, Z};
          pg8::gemm_phase<EpiPool, pg8::StaticOrder, true, true>(lds, g, S, E, wave_s); }
    }
    SEAM(3);
    if (IN(4)) for (int rep_ = 0; rep_ < 1 + ((PROBE_MASK >> 4) & 1); ++rep_) {
        for (int v = vcu; v < 256; v += G) { const int bh = v >> 2, j = v & 3;
#pragma unroll 1
            for (int i = 0; i < 4; ++i) { const int qb = (i == 0) ? 15 - j : (i == 1) ? 8 + j : (i == 2) ? 7 - j : j;
                att::attn_unit(bh >> 3, bh & 7, qb, Qb, KN, KR, VT, Z, cs, YA, lds, wave_s); } }
    }
    SEAM(4);
    if (IN(5)) for (int rep_ = 0; rep_ < 1 + ((PROBE_MASK >> 5) & 1); ++rep_) {
        { pg8::Gemm g{YA, WaT, M, 1024, 512, 512, 512}; pg8::StaticOrder S; S.init(M, 1024, G, bx); EpiMerge<false> E{TT, Z, nullptr, OGMA};
          pg8::gemm_phase<EpiMerge<false>, pg8::StaticOrder, true, true>(lds, g, S, E, wave_s); }
        asm volatile("s_waitcnt vmcnt(0)" ::: "memory"); __syncthreads();
        __builtin_amdgcn_fence(__ATOMIC_RELEASE, "agent"); __builtin_amdgcn_fence(__ATOMIC_ACQUIRE, "agent"); asm volatile("s_waitcnt vmcnt(0)" ::: "memory"); __syncthreads();
        { pg8::Gemm g{YP, WpT, M, 1024, 512, 512, 512}; pg8::StaticOrder S; S.init(M, 1024, G, bx); EpiMerge<true> E{MG, Z, TT, OGMP};
          pg8::gemm_phase<EpiMerge<true>, pg8::StaticOrder, true, true>(lds, g, S, E, wave_s); }
    }
    SEAM(5);
    if (IN(6)) for (int rep_ = 0; rep_ < 1 + ((PROBE_MASK >> 6) & 1); ++rep_) {
        pg8::Gemm g{MG, WoT, M, 1024, 1024, 1024, 1024}; pg8::StaticOrder S; S.init(M, 1024, G, bx); EpiOut E{x, a.out};
        pg8::gemm_phase<EpiOut, pg8::StaticOrder, true, true>(lds, g, S, E, wave_s);
    }
    SEAM(6);
    if (IN(7)) for (int rep_ = 0; rep_ < 1 + ((PROBE_MASK >> 7) & 1); ++rep_) { PHASE_IDS
        for (int m = gw; m < M; m += NGW) {
            f32x4* xr = (f32x4*)(a.out + (size_t)m * DM) + lane; const f32x4* gr = (const f32x4*)norm_final + lane;
            f32x4 v[4]; float s = 0.f;
#pragma unroll
            for (int j = 0; j < 4; ++j) { v[j] = xr[64 * j]; s += (v[j][0] * v[j][0] + v[j][1] * v[j][1]) + (v[j][2] * v[j][2] + v[j][3] * v[j][3]); }
            const float rstd = rsqrtf(wave_sum(s) * (1.f / DM) + EPS);
#pragma unroll
            for (int j = 0; j < 4; ++j) { const f32x4 g = gr[64 * j]; f32x4 o = {v[j][0] * rstd * g[0], v[j][1] * rstd * g[1], v[j][2] * rstd * g[2], v[j][3] * rstd * g[3]}; xr[64 * j] = o; }
        }
    }
#undef IN
#undef SEAM
}

#ifndef MK_N_LAUNCHES
#define MK_N_LAUNCHES 1
#endif
extern "C" void kernel_launch(void* const* d_in, const int* in_sizes, int n_in, void* d_out, int out_size, void* d_ws, size_t ws_size, hipStream_t stream) {
    static int grid = 0;
    if (grid == 0) {
        if (n_in != 13 || out_size != M * DM || ws_size < WS_END) { fprintf(stderr, "kernel_launch: unexpected shapes: n_in %d out %d ws %zu (need %zu)\n", n_in, out_size, ws_size, (size_t)WS_END); grid = -1; return; }
        int dev = 0, cus = 0, per_cu = 0;
        hipGetDevice(&dev); hipDeviceGetAttribute(&cus, hipDeviceAttributeMultiprocessorCount, dev);
        if (hipFuncSetAttribute((const void*)mk_fwd, hipFuncAttributeMaxDynamicSharedMemorySize, LDS_BYTES) != hipSuccess) { fprintf(stderr, "kernel_launch: hipFuncSetAttribute failed\n"); grid = -1; return; }
        hipOccupancyMaxActiveBlocksPerMultiprocessor(&per_cu, (const void*)mk_fwd, NTHR, LDS_BYTES);
        if (per_cu < 1) { fprintf(stderr, "kernel_launch: occupancy query says %d blocks per CU\n", per_cu); per_cu = 1; }
        (void)hipGetLastError();
        grid = cus * 1;
    }
    if (grid < 0) return;
    (void)hipMemsetAsync((char*)d_ws + WS_BAR, 0, 16384, stream);
    Args a{};
    for (int i = 0; i < 13; ++i) a.in[i] = (const float*)d_in[i];
    a.out = (float*)d_out; a.ws = (unsigned char*)d_ws;
    constexpr int NPH = 8;
    for (int li = 0; li < MK_N_LAUNCHES; ++li) {
        a.ph_lo = (MK_N_LAUNCHES == 1) ? 0 : li; a.ph_hi = (MK_N_LAUNCHES == 1) ? NPH : li + 1;
        void* args[] = {&a};
        hipError_t e = hipLaunchCooperativeKernel((const void*)mk_fwd, dim3(grid), dim3(NTHR), args, LDS_BYTES, stream);
        if (e != hipSuccess) { fprintf(stderr, "kernel_launch: cooperative launch failed: %s (grid %d)\n", hipGetErrorString(e), grid); break; }
    }
}
```
